# Optimizing an MI355X kernel written in HIP

```python
import math
import jax, jax.numpy as jnp
from jax import lax
import numpy as np

D_MODEL = 1024
BATCH = 16
SEQ = 2048
DEPTH = 1

N_META = 16
D_MIX = D_MODEL
C_CONV = D_MIX // 2
CONV_GROUPS = 8
CONV_WIDTH = 31
GLA_V = D_MIX - C_CONV
GLA_HEADS = 4
GLA_DV = GLA_V // GLA_HEADS
GLA_DK = GLA_DV // 2
GLA_K = GLA_HEADS * GLA_DK
GATE_RANK = 16
GATE_TAU = 16.0
CHUNK = 64
META_PAD = CHUNK - N_META
D_FF = int(math.ceil(D_MODEL * 8 / 3 / 256) * 256)
RMS_EPS = 1e-6
LN_EPS = 1e-5

IN_SPLITS = [C_CONV, C_CONV, GLA_K, GLA_K, GLA_V, GLA_V, GATE_RANK]
D_IN = sum(IN_SPLITS)

kernel_name = "hymba_conformer_conv_gla_hybrid"


def rms_norm(x, g):
    xf = x.astype(jnp.float32)
    y = xf * lax.rsqrt(jnp.mean(xf * xf, axis=-1, keepdims=True) + RMS_EPS)
    return (y * g.astype(jnp.float32)).astype(x.dtype)


def conv_group(u_val, u_gate, conv_w, conv_b, ln_g, ln_b):
    v = u_val * jax.nn.sigmoid(u_gate)
    y = lax.conv_general_dilated(
        v, conv_w[:, None, :].astype(v.dtype),
        window_strides=(1,), padding=((CONV_WIDTH - 1, 0),),
        dimension_numbers=("NWC", "WIO", "NWC"),
        feature_group_count=C_CONV) + conv_b
    yf = y.astype(jnp.float32)
    mu = jnp.mean(yf, axis=-1, keepdims=True)
    var = jnp.mean(jnp.square(yf - mu), axis=-1, keepdims=True)
    yf = (yf - mu) * lax.rsqrt(var + LN_EPS) * ln_g.astype(jnp.float32) + ln_b.astype(jnp.float32)
    return jax.nn.silu(yf).astype(u_val.dtype)


def _to_chunks(t, d):
    b, lp, _ = t.shape
    return t.reshape(b, lp // CHUNK, CHUNK, GLA_HEADS, d).transpose(0, 1, 3, 2, 4)


def gla_group(q, k, v, g, gate_lr, w_gate2, gate_b, norm_g):
    dt = q.dtype
    bsz, seq_len, _ = q.shape
    f = lambda t: t.astype(jnp.float32)
    log_a = jax.nn.log_sigmoid(f(gate_lr) @ f(w_gate2) + f(gate_b)) / GATE_TAU
    pad = lambda t: jnp.pad(f(t), ((0, 0), (META_PAD, 0), (0, 0)))
    qc = _to_chunks(pad(q), GLA_DK) * (GLA_DK ** -0.5)
    kc = _to_chunks(pad(k), GLA_DK)
    vc = _to_chunks(pad(v), GLA_DV)
    bc = jnp.cumsum(_to_chunks(pad(log_a), GLA_DK), axis=3)
    b_last = bc[:, :, :, -1:, :]

    q_in = qc * jnp.exp(bc)
    k_in = kc * jnp.exp(-bc)
    causal = jnp.tril(jnp.ones((CHUNK, CHUNK), dtype=bool))
    scores = jnp.einsum("bnhid,bnhjd->bnhij", q_in, k_in)
    scores = jnp.where(causal, scores, 0.0)
    o_intra = jnp.einsum("bnhij,bnhje->bnhie", scores, vc)

    kv = jnp.einsum("bnhjd,bnhje->bnhde", kc * jnp.exp(b_last - bc), vc)
    decay = jnp.exp(b_last[:, :, :, 0, :])

    def step(state, inp):
        dec, kv_n = inp
        return dec[..., None] * state + kv_n, state

    s0 = jnp.zeros((bsz, GLA_HEADS, GLA_DK, GLA_DV), jnp.float32)
    _, s_prev = lax.scan(step, s0, (decay.swapaxes(0, 1), kv.swapaxes(0, 1)))
    s_prev = s_prev.swapaxes(0, 1)
    o_inter = jnp.einsum("bnhid,bnhde->bnhie", q_in, s_prev)

    o = (o_intra + o_inter).transpose(0, 1, 3, 2, 4).reshape(bsz, -1, GLA_HEADS, GLA_DV)[:, META_PAD:]
    o = o * lax.rsqrt(jnp.mean(o * o, axis=-1, keepdims=True) + RMS_EPS) * f(norm_g)
    o = o * jax.nn.silu(f(g)).reshape(bsz, seq_len, GLA_HEADS, GLA_DV)
    return o.reshape(bsz, seq_len, GLA_V).astype(dt)


def swiglu(x, w_gate, w_up, w_down):
    return (jax.nn.silu(x @ w_gate) * (x @ w_up)) @ w_down


def setup_inputs(seed: int = 0) -> dict:
    key = jax.random.key(seed)
    ks = jax.random.split(key, 20)
    n = lambda k, shape, s: jax.random.normal(k, shape, jnp.float32) * s
    return {
        "x": n(ks[0], (BATCH, SEQ, D_MODEL), 1.0),
        "meta_tokens": n(ks[1], (N_META, D_MODEL), 1.0),
        "norm_mix_g": 1.0 + n(ks[2], (DEPTH, D_MODEL), 0.02),
        "w_in": n(ks[3], (DEPTH, D_MODEL, D_IN), D_MODEL ** -0.5),
        "conv_w": n(ks[4], (DEPTH, CONV_WIDTH, C_CONV), CONV_WIDTH ** -0.5),
        "conv_b": n(ks[5], (DEPTH, C_CONV), 0.02),
        "conv_ln_g": 1.0 + n(ks[6], (DEPTH, C_CONV), 0.02),
        "conv_ln_b": n(ks[7], (DEPTH, C_CONV), 0.02),
        "gla_w_gate2": n(ks[8], (DEPTH, GATE_RANK, GLA_K), GATE_RANK ** -0.5),
        "gla_gate_b": n(ks[9], (DEPTH, GLA_K), 0.1),
        "gla_norm_g": 1.0 + n(ks[10], (DEPTH, GLA_DV), 0.02),
        "w_out": n(ks[11], (DEPTH, D_MIX, D_MODEL), D_MIX ** -0.5),
        "norm_ffn_g": 1.0 + n(ks[12], (DEPTH, D_MODEL), 0.02),
        "w_ffn_gate": n(ks[13], (DEPTH, D_MODEL, D_FF), D_MODEL ** -0.5),
        "w_ffn_up": n(ks[14], (DEPTH, D_MODEL, D_FF), D_MODEL ** -0.5),
        "w_ffn_down": n(ks[15], (DEPTH, D_FF, D_MODEL), D_FF ** -0.5),
        "norm_final_g": 1.0 + n(ks[16], (D_MODEL,), 0.02),
    }


def reference(x, meta_tokens, norm_mix_g, w_in, conv_w, conv_b, conv_ln_g, conv_ln_b,
              gla_w_gate2, gla_gate_b, gla_norm_g, w_out, norm_ffn_g, w_ffn_gate,
              w_ffn_up, w_ffn_down, norm_final_g):
    bsz = x.shape[0]
    meta = jnp.broadcast_to(meta_tokens[None].astype(x.dtype), (bsz, N_META, D_MODEL))
    h = jnp.concatenate([meta, x], axis=1)
    split_idx = list(np.cumsum(IN_SPLITS)[:-1])
    for l in range(DEPTH):
        u = rms_norm(h, norm_mix_g[l]) @ w_in[l]
        c_val, c_gate, q, k, v, g, gate_lr = jnp.split(u, split_idx, axis=-1)
        y_conv = conv_group(c_val, c_gate, conv_w[l], conv_b[l], conv_ln_g[l], conv_ln_b[l])
        y_gla = gla_group(q, k, v, g, gate_lr, gla_w_gate2[l], gla_gate_b[l], gla_norm_g[l])
        h = h + jnp.concatenate([y_conv, y_gla], axis=-1) @ w_out[l]
        h = h + swiglu(rms_norm(h, norm_ffn_g[l]), w_ffn_gate[l], w_ffn_up[l], w_ffn_down[l])
    y = rms_norm(h, norm_final_g)
    return y[:, N_META:]
```

```cpp
#include <hip/hip_runtime.h>
#include <hip/hip_cooperative_groups.h>
#include <cstdio>
#include <cstdint>
namespace cg = cooperative_groups;
namespace pg8 {
#define PG8_LAS __attribute__((address_space(3)))
typedef unsigned short bf16_t;
typedef short bf16x8 __attribute__((ext_vector_type(8)));
typedef float f32x4 __attribute__((ext_vector_type(4)));
typedef unsigned u32x4 __attribute__((ext_vector_type(4)));
typedef unsigned u32x2 __attribute__((ext_vector_type(2)));
constexpr int BM = 256, BK = 64, HALF = 128, HTB = HALF * BK * 2  , STAGE_BYTES = 8 * HTB, NXCD = 8, WGM = 8;

__host__ __device__ __forceinline__ int lds_byte(int r, int c) { const int st = (r >> 4) * 2 + (c >> 5), rr = r & 15, cc = c & 31, ob = rr * 64 + cc * 2; return st * 1024 + (ob ^ (((ob >> 9) & 1) << 5)); }
__host__ __device__ __forceinline__ void stage_rc(int b, int& R, int& C) { const int st = b / 1024, sb = b % 1024, swz = sb ^ (((sb >> 9) & 1) << 5); R = (st >> 1) * 16 + swz / 64; C = (st & 1) * 32 + (swz % 64) / 2; }
__host__ __device__ __forceinline__ int perm32(int rho) { const int n = rho >> 4, i = rho & 15; return 8 * (i >> 2) + 4 * n + (i & 3); }

struct Unit { int pm, pn; };
struct Gemm { const bf16_t* A; const bf16_t* Bt; int M, N, K; };

struct StaticOrder {
    int nM, nN, nwg, G, c;
    __host__ __device__ void init(int M, int N, int G_, int c_) { nM = M / BM; nN = N / BM; nwg = nM * nN; G = G_; c = c_; }
    __host__ __device__ bool next(int i, Unit& u) const {
        const long L = (long)i * G + c; if (L >= nwg) return false;
        int wgid = (int)L; { const int q = nwg / NXCD, r = nwg % NXCD, xcd = wgid % NXCD, off = wgid / NXCD; wgid = (xcd < r ? xcd * (q + 1) : r * (q + 1) + (xcd - r) * q) + off; }
        const int nig = WGM * nN, gid = wgid / nig, fm = gid * WGM, gsz = (nM - fm) < WGM ? (nM - fm) : WGM;
        u.pm = fm + ((wgid % nig) % gsz); u.pn = (wgid % nig) / gsz; return true;
    }
    __device__ __forceinline__ void a_ready(const Unit&) const {}
    __device__ __forceinline__ void done(const Unit&) const {}
};
__device__ __forceinline__ unsigned cvt_pk_bf16(float lo, float hi) { unsigned r; asm volatile("v_cvt_pk_bf16_f32 %0, %1, %2" : "=v"(r) : "v"(lo), "v"(hi)); return r; }
typedef float f32x2 __attribute__((ext_vector_type(2)));
template <class Epi, class Sched, bool ALIGN_EPI = false, bool SP2 = false>
__device__ __forceinline__ void gemm_phase(PG8_LAS unsigned char* lds, const Gemm g, const Sched& S, const Epi& E) {
    const int tid = threadIdx.x, wid = __builtin_amdgcn_readfirstlane(tid >> 6), lane = tid & 63, wr = wid >> 2, wc = wid & 3, fr = lane & 15, fq = lane >> 4;
    const int K = g.K, nt = K / BK;
    unsigned voffA[2], voffB[2];
#pragma unroll
    for (int i = 0; i < 2; ++i) { int R, C; stage_rc(tid * 16 + i * 8192, R, C); const int Rb = Epi::PERM ? ((R & ~31) + perm32(R & 31)) : R;
        voffA[i] = (unsigned)(R * K + C) * 2u; voffB[i] = (unsigned)(Rb * K + C) * 2u; }
    const size_t kstep = (size_t)(BK * 2);
    const size_t hstep = (size_t)HALF * K * 2;
    const size_t tstep = 2 * hstep;
    const unsigned ldsw = (unsigned)wid * 1024u;
    const int aoff = lds_byte(wr * 64 + fr, fq * 8), boff = lds_byte(wc * 32 + fr, fq * 8);
#define PG8_SA(b, h) (((b) * 2 + (h)) * HTB)
#define PG8_SB(b, h) ((4 + (b) * 2 + (h)) * HTB)
#define PG8_STAGE(bufoff, gbase, voff) do { _Pragma("unroll") for (int _i = 0; _i < 2; ++_i) \
        __builtin_amdgcn_global_load_lds((const unsigned*)((const char*)(gbase) + (voff)[_i]), (PG8_LAS unsigned*)(lds + (bufoff) + ldsw + _i * 8192), 16, 0, 0); } while (0)
#define PG8_LDA(dst, b, h) do { _Pragma("unroll") for (int m = 0; m < 4; ++m) _Pragma("unroll") for (int k = 0; k < 2; ++k) dst[m][k] = *(const PG8_LAS bf16x8*)(lds + PG8_SA(b, h) + aoff + m * 2048 + k * 1024); } while (0)
#define PG8_LDB(dst, b, h) do { _Pragma("unroll") for (int n = 0; n < 2; ++n) _Pragma("unroll") for (int k = 0; k < 2; ++k) dst[n][k] = *(const PG8_LAS bf16x8*)(lds + PG8_SB(b, h) + boff + n * 2048 + k * 1024); } while (0)
#define PG8_MMA(ai, bj, At, Bt) do { __builtin_amdgcn_s_setprio(1); _Pragma("unroll") for (int m = 0; m < 4; ++m) _Pragma("unroll") for (int n = 0; n < 2; ++n) _Pragma("unroll") for (int k = 0; k < 2; ++k) \
        acc[ai][bj][m][n] = __builtin_amdgcn_mfma_f32_16x16x32_bf16(Bt[n][k], At[m][k], acc[ai][bj][m][n], 0, 0, 0); __builtin_amdgcn_s_setprio(0); } while (0)
#define PG8_WAIT_V(n) asm volatile("s_waitcnt vmcnt(" #n ")" ::: "memory")
#define PG8_WAIT_L(n) asm volatile("s_waitcnt lgkmcnt(" #n ")" ::: "memory")
#define PG8_BAR __builtin_amdgcn_s_barrier()
#define PG8_SCHED __builtin_amdgcn_sched_barrier(0)
    Unit cur, nxt; int ui = 0;
    if (!S.next(0, cur)) return;
    f32x4 acc[2][2][4][2];
#pragma unroll
    for (int a = 0; a < 2; ++a)
#pragma unroll
        for (int b = 0; b < 2; ++b)
#pragma unroll
            for (int m = 0; m < 4; ++m)
#pragma unroll
                for (int n = 0; n < 2; ++n) acc[a][b][m][n] = (f32x4){0.f, 0.f, 0.f, 0.f};
    bf16x8 At[4][2], B0[2][2], B1[2][2];
    const char* cA = (const char*)g.A + (size_t)cur.pm * tstep; const char* cB = (const char*)g.Bt + (size_t)cur.pn * tstep;
    S.a_ready(cur);
    if constexpr (SP2) {
        PG8_STAGE(PG8_SB(0, 0), cB, voffB); PG8_STAGE(PG8_SB(0, 1), cB + hstep, voffB); PG8_STAGE(PG8_SA(0, 0), cA, voffA); PG8_STAGE(PG8_SA(0, 1), cA + hstep, voffA);
        if (wr == 1) PG8_BAR;
        PG8_WAIT_V(2); PG8_BAR;
        PG8_STAGE(PG8_SB(1, 0), cB + kstep, voffB); PG8_STAGE(PG8_SA(1, 0), cA + kstep, voffA); PG8_STAGE(PG8_SB(1, 1), cB + hstep + kstep, voffB);
        PG8_WAIT_V(6); PG8_BAR;
    } else {
        PG8_STAGE(PG8_SB(0, 0), cB, voffB); PG8_STAGE(PG8_SA(0, 0), cA, voffA); PG8_STAGE(PG8_SB(0, 1), cB + hstep, voffB); PG8_STAGE(PG8_SA(0, 1), cA + hstep, voffA);
        if (wr == 1) PG8_BAR;
        PG8_WAIT_V(4); PG8_BAR;
        PG8_STAGE(PG8_SB(1, 0), cB + kstep, voffB); PG8_STAGE(PG8_SA(1, 0), cA + kstep, voffA); PG8_STAGE(PG8_SB(1, 1), cB + hstep + kstep, voffB);
        PG8_WAIT_V(6); PG8_BAR;
    }
    for (;;) {
        const bool has_next = S.next(ui + 1, nxt);
        const char* nA = has_next ? (const char*)g.A + (size_t)nxt.pm * tstep : cA; const char* nB = has_next ? (const char*)g.Bt + (size_t)nxt.pn * tstep : cB;
        for (int t = 0; t < nt; t += 2) {
            const bool last = (t == nt - 2);
            const char* a1 = cA + (size_t)(t + 1) * kstep;
            const char* a2 = last ? nA : cA + (size_t)(t + 2) * kstep; const char* b2 = last ? nB : cB + (size_t)(t + 2) * kstep;
            const char* a3 = a2 + kstep; const char* b3 = b2 + kstep;
            if (last && has_next) S.a_ready(nxt);
            if constexpr (SP2) {
            PG8_LDB(B0, 0, 0); PG8_LDB(B1, 0, 1); PG8_SCHED; PG8_LDA(At, 0, 0); PG8_STAGE(PG8_SA(1, 1), a1 + hstep, voffA);
            PG8_WAIT_V(8); PG8_WAIT_L(0); PG8_BAR; PG8_MMA(0, 0, At, B0); PG8_MMA(0, 1, At, B1); PG8_BAR; PG8_SCHED;
            PG8_LDA(At, 0, 1); PG8_STAGE(PG8_SB(0, 0), b2, voffB); PG8_STAGE(PG8_SB(0, 1), b2 + hstep, voffB); PG8_STAGE(PG8_SA(0, 0), a2, voffA);
            PG8_WAIT_V(8); PG8_WAIT_L(0); PG8_BAR; PG8_MMA(1, 0, At, B0); PG8_MMA(1, 1, At, B1); PG8_BAR; PG8_SCHED;
            PG8_LDB(B0, 1, 0); PG8_LDB(B1, 1, 1); PG8_SCHED; PG8_LDA(At, 1, 0); PG8_STAGE(PG8_SA(0, 1), a2 + hstep, voffA);
            PG8_WAIT_V(8); PG8_WAIT_L(0); PG8_BAR; PG8_MMA(0, 0, At, B0); PG8_MMA(0, 1, At, B1); PG8_BAR; PG8_SCHED;
            PG8_LDA(At, 1, 1); PG8_STAGE(PG8_SB(1, 0), b3, voffB); PG8_STAGE(PG8_SB(1, 1), b3 + hstep, voffB); PG8_STAGE(PG8_SA(1, 0), a3, voffA);
            PG8_WAIT_V(8); PG8_WAIT_L(0); PG8_BAR; PG8_MMA(1, 0, At, B0); PG8_MMA(1, 1, At, B1); PG8_BAR; PG8_SCHED;
            } else {
            PG8_LDB(B0, 0, 0); PG8_SCHED; PG8_LDA(At, 0, 0); PG8_STAGE(PG8_SA(1, 1), a1 + hstep, voffA);
            PG8_WAIT_L(8); PG8_BAR; PG8_WAIT_L(0); PG8_MMA(0, 0, At, B0); PG8_BAR; PG8_SCHED;
            PG8_LDB(B1, 0, 1); PG8_STAGE(PG8_SB(0, 0), b2, voffB);
            PG8_BAR; PG8_WAIT_L(0); PG8_MMA(0, 1, At, B1); PG8_BAR;
            PG8_LDA(At, 0, 1); PG8_STAGE(PG8_SA(0, 0), a2, voffA);
            PG8_BAR; PG8_WAIT_L(0); PG8_MMA(1, 0, At, B0); PG8_BAR; PG8_SCHED;
            PG8_STAGE(PG8_SB(0, 1), b2 + hstep, voffB);
            PG8_WAIT_V(6); PG8_BAR; PG8_MMA(1, 1, At, B1); PG8_BAR;
            PG8_LDB(B0, 1, 0); PG8_SCHED; PG8_LDA(At, 1, 0); PG8_STAGE(PG8_SA(0, 1), a2 + hstep, voffA);
            PG8_WAIT_L(8); PG8_BAR; PG8_WAIT_L(0); PG8_MMA(0, 0, At, B0); PG8_BAR; PG8_SCHED;
            PG8_LDB(B1, 1, 1); PG8_STAGE(PG8_SB(1, 0), b3, voffB);
            PG8_BAR; PG8_WAIT_L(0); PG8_MMA(0, 1, At, B1); PG8_BAR;
            PG8_LDA(At, 1, 1); PG8_STAGE(PG8_SA(1, 0), a3, voffA);
            PG8_BAR; PG8_WAIT_L(0); PG8_MMA(1, 0, At, B0); PG8_BAR; PG8_SCHED;
            PG8_STAGE(PG8_SB(1, 1), b3 + hstep, voffB);
            PG8_WAIT_V(6); PG8_BAR; PG8_MMA(1, 1, At, B1); PG8_BAR;
            }
        }
        if constexpr (ALIGN_EPI) { if (wr == 0) PG8_BAR; }
        if constexpr (!Epi::AFTER_DRAIN) { E(acc, cur, wr, wc, fr, fq); S.done(cur); }
        if (!has_next) break;
#pragma unroll
        for (int a = 0; a < 2; ++a)
#pragma unroll
            for (int b = 0; b < 2; ++b)
#pragma unroll
                for (int m = 0; m < 4; ++m)
#pragma unroll
                    for (int n = 0; n < 2; ++n) acc[a][b][m][n] = (f32x4){0.f, 0.f, 0.f, 0.f};
        cur = nxt; cA = nA; cB = nB; ++ui;
        if constexpr (ALIGN_EPI) { if (wr == 1) PG8_BAR; }
    }
    PG8_WAIT_V(0);
    if constexpr (!ALIGN_EPI) { if (wr == 0) PG8_BAR; }
    PG8_BAR;
    if constexpr (Epi::AFTER_DRAIN) { E.fused(acc, cur, wr, wc, fr, fq, lds, wid, lane); S.done(cur); }
#undef PG8_SA
#undef PG8_SB
#undef PG8_STAGE
#undef PG8_LDA
#undef PG8_LDB
#undef PG8_MMA
#undef PG8_WAIT_V
#undef PG8_WAIT_L
#undef PG8_BAR
#undef PG8_SCHED
}
}

constexpr int NB = 16, SEQ = 2048, D = 1024, M = NB * SEQ, NMETA = 16;
constexpr int CC = 512, CWID = 31, NH = 4, DK = 64, DV = 128, RANK = 16, DFF = 2816, DIN = 2576, NU = 2560;
constexpr int OFF_CV = 0, OFF_CG = 512, OFF_Q = 1024, OFF_K = 1280, OFF_V = 1536, OFF_G = 2048, OFF_LR = 2560;
constexpr float RMS_EPS = 1e-6f, LNC_EPS = 1e-5f;
constexpr int NWAVES = 8, NTHR = 512;
#ifndef MK_N_LAUNCHES
#define MK_N_LAUNCHES 1
#endif
constexpr int N_PHASES = 7;

constexpr size_t MiB = 1u << 20;
constexpr size_t WS_RSTD1 = 1 * MiB, WS_SQ2 = WS_RSTD1 + 128 * 1024, WS_SQ3 = WS_SQ2 + 128 * 1024, WS_UMETA = 2 * MiB;
constexpr size_t WS_WIN = 4 * MiB, WS_WOUT = 10 * MiB, WS_WGU = 12 * MiB, WS_WDN = 24 * MiB, WS_GLR = 30 * MiB;
constexpr size_t WS_HB = 32 * MiB;
constexpr size_t WS_U = 96 * MiB;
constexpr size_t WS_Y = 256 * MiB;
constexpr size_t WS_ACT = 96 * MiB;
constexpr size_t WS_H2 = 320 * MiB;
constexpr size_t WS_END = 448 * MiB;
constexpr int LDS_BYTES = 147456;

#define GAS __attribute__((address_space(1)))
#define LAS __attribute__((address_space(3)))
typedef unsigned short bf16;
typedef unsigned v4u __attribute__((ext_vector_type(4)));
typedef unsigned v2u __attribute__((ext_vector_type(2)));
typedef float f32x4 __attribute__((ext_vector_type(4)));
typedef short bf16x8 __attribute__((ext_vector_type(8)));
#define LDS_WAIT() asm volatile("s_waitcnt lgkmcnt(0)" ::: "memory")

__device__ __forceinline__ unsigned f2bf(float f) { unsigned u = __builtin_bit_cast(unsigned, f); return (u + 0x7fffu + ((u >> 16) & 1u)) >> 16; }
__device__ __forceinline__ unsigned pk2(float lo, float hi) { return f2bf(lo) | (f2bf(hi) << 16); }
__device__ __forceinline__ float bf2f(unsigned b) { return __builtin_bit_cast(float, b << 16); }
__device__ __forceinline__ float bflo(unsigned w) { return __builtin_bit_cast(float, w << 16); }
__device__ __forceinline__ float bfhi(unsigned w) { return __builtin_bit_cast(float, w & 0xffff0000u); }
__device__ __forceinline__ float sigmoidf_(float x) { return __builtin_amdgcn_rcpf(1.0f + __expf(-x)); }
__device__ __forceinline__ float siluf_(float x) { return x * sigmoidf_(x); }
__device__ __forceinline__ float wave_sum(float v) {
#pragma unroll
    for (int o = 1; o < 64; o <<= 1) v += __shfl_xor(v, o);
    return v;
}

namespace pg8 {
struct EpiU {
    static constexpr bool PERM = true, AFTER_DRAIN = false;
    bf16_t* O; const float* rstd;
    __device__ __forceinline__ void operator()(const f32x4 (&acc)[2][2][4][2], const Unit& u, int wr, int wc, int fr, int fq) const {
        const int row0 = u.pm * BM + wr * 64 + fr, col0 = u.pn * BM + wc * 32 + 8 * fq;
#pragma unroll
        for (int ai = 0; ai < 2; ++ai)
#pragma unroll
            for (int m = 0; m < 4; ++m) { const int row = row0 + ai * HALF + m * 16; const float rs = rstd[row]; bf16_t* rowp = O + (size_t)row * NU + col0;
#pragma unroll
                for (int bj = 0; bj < 2; ++bj) { const f32x4 v0 = acc[ai][bj][m][0] * rs, v1 = acc[ai][bj][m][1] * rs;
                    u32x4 w; w.x = cvt_pk_bf16(v0[0], v0[1]); w.y = cvt_pk_bf16(v0[2], v0[3]); w.z = cvt_pk_bf16(v1[0], v1[1]); w.w = cvt_pk_bf16(v1[2], v1[3]);
                    *(u32x4*)(rowp + bj * HALF) = w; } }
    }
};
template <bool WITH_BF16> struct EpiRes {
    static constexpr bool PERM = false, AFTER_DRAIN = false;
    const float* base; float* out; bf16_t* ob; float* sq;
    __device__ __forceinline__ void operator()(const f32x4 (&acc)[2][2][4][2], const Unit& u, int wr, int wc, int fr, int fq) const {
        const int row0 = u.pm * BM + wr * 64 + fr, col0 = u.pn * BM + wc * 32 + 4 * fq;
#pragma unroll
        for (int ai = 0; ai < 2; ++ai)
#pragma unroll
            for (int m = 0; m < 4; ++m) { const int row = row0 + ai * HALF + m * 16; const size_t off = (size_t)row * D + col0; float ss = 0.f;
#pragma unroll
                for (int bj = 0; bj < 2; ++bj)
#pragma unroll
                    for (int n = 0; n < 2; ++n) { const f32x4 bs = *(const f32x4*)(base + off + bj * HALF + n * 16); const f32x4 h = bs + acc[ai][bj][m][n];
                        *(f32x4*)(out + off + bj * HALF + n * 16) = h;
                        if (WITH_BF16) { u32x2 w; w.x = cvt_pk_bf16(h[0], h[1]); w.y = cvt_pk_bf16(h[2], h[3]); *(u32x2*)(ob + off + bj * HALF + n * 16) = w; }
                        ss += (h[0] * h[0] + h[1] * h[1]) + (h[2] * h[2] + h[3] * h[3]); }
                ss += __shfl_xor(ss, 16); ss += __shfl_xor(ss, 32);
                if (fq == 0) atomicAdd(sq + row, ss);
                asm volatile("" ::: "memory"); }
    }
};
struct EpiAct {
    static constexpr bool PERM = true, AFTER_DRAIN = false;
    bf16_t* O; const float* sq;
    __device__ __forceinline__ void operator()(const f32x4 (&acc)[2][2][4][2], const Unit& u, int wr, int wc, int fr, int fq) const {
        const int row0 = u.pm * BM + wr * 64 + fr, col0 = u.pn * HALF + wc * 32 + 8 * fq;
#pragma unroll
        for (int ai = 0; ai < 2; ++ai)
#pragma unroll
            for (int m = 0; m < 4; ++m) { const int row = row0 + ai * HALF + m * 16; const float rs = __builtin_amdgcn_rsqf(sq[row] * (1.0f / D) + 1e-6f);
                float r[8];
#pragma unroll
                for (int n = 0; n < 2; ++n)
#pragma unroll
                    for (int j = 0; j < 4; ++j) { const float g = acc[ai][0][m][n][j] * rs, up = acc[ai][1][m][n][j] * rs; r[n * 4 + j] = g * __builtin_amdgcn_rcpf(1.0f + __expf(-g)) * up; }
                u32x4 w; w.x = cvt_pk_bf16(r[0], r[1]); w.y = cvt_pk_bf16(r[2], r[3]); w.z = cvt_pk_bf16(r[4], r[5]); w.w = cvt_pk_bf16(r[6], r[7]);
                *(u32x4*)(O + (size_t)row * DFF + col0) = w; }
    }
};
}

struct Frame {
    LAS unsigned char* lds;
    int tid, lane, wave, G, bid;
    const float *x, *meta, *g_mix, *w_in, *conv_w, *conv_b, *cln_g, *cln_b, *w_gate2, *gate_b, *gnorm_g, *w_out, *g_ffn, *w_fg, *w_fu, *w_fd, *g_fin;
    float* out;
    float *rstd1, *sq2, *sq3, *umeta, *glr, *h2;
    bf16 *Wt_in, *Wt_out, *Wt_gu, *Wt_dn, *hb, *u, *y, *act;
};

__device__ __forceinline__ void p0_transpose_item(const float* W, int ldw, int col_off, const float* gsc, bf16* WT, int Kd, int dst_row, LAS float* scr, int k0, int lane) {
#pragma unroll 8
    for (int i = 0; i < 32; ++i) { const int kk = 2 * i + (lane >> 5); float v = W[(size_t)(k0 + kk) * ldw + col_off + (lane & 31)]; if (gsc) v *= gsc[k0 + kk]; scr[kk * 33 + (lane & 31)] = v; }
    LDS_WAIT(); asm volatile("" ::: "memory");
    const int c = lane & 7;
#pragma unroll
    for (int j = 0; j < 4; ++j) { const int n = (lane >> 3) + 8 * j; const LAS float* s = scr + (8 * c) * 33 + n;
        v4u o; o.x = pk2(s[0 * 33], s[1 * 33]); o.y = pk2(s[2 * 33], s[3 * 33]); o.z = pk2(s[4 * 33], s[5 * 33]); o.w = pk2(s[6 * 33], s[7 * 33]);
        *(v4u*)(WT + (size_t)(dst_row + n) * Kd + k0 + 8 * c) = o; }
    LDS_WAIT(); asm volatile("" ::: "memory");
}
constexpr int P0_SCR_BYTES = 8704, P0_WLR_OFF = 8 * P0_SCR_BYTES, WLR_STRIDE = 1032;
static_assert(P0_WLR_OFF + 16 * WLR_STRIDE * 2 <= LDS_BYTES, "P0 LDS");
__device__ __forceinline__ void p0_rows_item(Frame& F, int grp) {
    const int lane = F.lane, r = lane & 15, q = lane >> 4; const int row = grp * 16 + r;
    const float* xr = F.x + (size_t)row * D + 16 * q; bf16* hr = F.hb + (size_t)row * D + 16 * q;
    const LAS bf16* wl = (const LAS bf16*)(F.lds + P0_WLR_OFF) + r * WLR_STRIDE + 16 * q;
    f32x4 acc = {0.f, 0.f, 0.f, 0.f}; float ss = 0.f;
#pragma unroll 4
    for (int kb = 0; kb < 16; ++kb) {
        const f32x4 a0 = *(const f32x4*)(xr + kb * 64), a1 = *(const f32x4*)(xr + kb * 64 + 4), a2 = *(const f32x4*)(xr + kb * 64 + 8), a3 = *(const f32x4*)(xr + kb * 64 + 12);
        ss += (a0[0] * a0[0] + a0[1] * a0[1]) + (a0[2] * a0[2] + a0[3] * a0[3]) + (a1[0] * a1[0] + a1[1] * a1[1]) + (a1[2] * a1[2] + a1[3] * a1[3])
            + (a2[0] * a2[0] + a2[1] * a2[1]) + (a2[2] * a2[2] + a2[3] * a2[3]) + (a3[0] * a3[0] + a3[1] * a3[1]) + (a3[2] * a3[2] + a3[3] * a3[3]);
        v4u p0, p1; p0.x = pk2(a0[0], a0[1]); p0.y = pk2(a0[2], a0[3]); p0.z = pk2(a1[0], a1[1]); p0.w = pk2(a1[2], a1[3]);
        p1.x = pk2(a2[0], a2[1]); p1.y = pk2(a2[2], a2[3]); p1.z = pk2(a3[0], a3[1]); p1.w = pk2(a3[2], a3[3]);
        *(v4u*)(hr + kb * 64) = p0; *(v4u*)(hr + kb * 64 + 8) = p1;
        const bf16x8 b0 = *(const LAS bf16x8*)(wl + kb * 64), b1 = *(const LAS bf16x8*)(wl + kb * 64 + 8);
        acc = __builtin_amdgcn_mfma_f32_16x16x32_bf16(__builtin_bit_cast(bf16x8, p0), b0, acc, 0, 0, 0);
        acc = __builtin_amdgcn_mfma_f32_16x16x32_bf16(__builtin_bit_cast(bf16x8, p1), b1, acc, 0, 0, 0);
    }
    ss += __shfl_xor(ss, 16); ss += __shfl_xor(ss, 32);
    const float rs = __builtin_amdgcn_rsqf(ss * (1.0f / D) + RMS_EPS);
    if (q == 0) F.rstd1[row] = rs;
#pragma unroll
    for (int i = 0; i < 4; ++i) { const float rsi = __shfl(rs, 4 * q + i); F.glr[(size_t)(grp * 16 + 4 * q + i) * RANK + r] = acc[i] * rsi; }
}
__device__ __forceinline__ void p0_meta_item(Frame& F, int item) {
    const int mp = item / 41, nb = item % 41, m0 = 2 * mp, n = nb * 64 + F.lane; const bool ok = n < DIN; const int nn = ok ? n : DIN - 1;
    const float* r0 = F.meta + (size_t)m0 * D; const float* r1 = r0 + D;
    float s0 = 0.f, s1 = 0.f;
#pragma unroll
    for (int j = 0; j < 16; ++j) { const float a = r0[F.lane + 64 * j], b = r1[F.lane + 64 * j]; s0 += a * a; s1 += b * b; }
    const float rs0 = __builtin_amdgcn_rsqf(wave_sum(s0) * (1.0f / D) + RMS_EPS), rs1 = __builtin_amdgcn_rsqf(wave_sum(s1) * (1.0f / D) + RMS_EPS);
    float a0 = 0.f, a1 = 0.f;
#pragma unroll 8
    for (int k = 0; k < D; ++k) { const float w = F.w_in[(size_t)k * DIN + nn] * F.g_mix[k]; a0 += r0[k] * w; a1 += r1[k] * w; }
    if (ok) { F.umeta[(size_t)m0 * DIN + n] = a0 * rs0; F.umeta[(size_t)(m0 + 1) * DIN + n] = a1 * rs1; }
}
__device__ __forceinline__ void p0_prep(Frame& F) {
    for (int i = F.bid * NTHR + F.tid; i < M; i += F.G * NTHR) { F.sq2[i] = 0.f; F.sq3[i] = 0.f; }
    { LAS bf16* wl = (LAS bf16*)(F.lds + P0_WLR_OFF);
      for (int idx = F.tid; idx < RANK * D; idx += NTHR) { const int k = idx >> 4, n = idx & 15; wl[n * WLR_STRIDE + k] = (bf16)f2bf(F.w_in[(size_t)k * DIN + OFF_LR + n] * F.g_mix[k]); } }
    __syncthreads();
    LAS float* scr = (LAS float*)(F.lds + F.wave * P0_SCR_BYTES);
    const int gw = F.bid * NWAVES + F.wave, NGW = F.G * NWAVES;
    constexpr int I_META = 8 * 41, I_ROWS = M / 16, I_IN = 16 * 80, I_OUT = 16 * 32, I_G = 16 * 88, I_U = I_G, I_D = 44 * 32;
    constexpr int NITEMS = I_META + I_ROWS + I_IN + I_OUT + I_G + I_U + I_D;
    for (int it0 = gw; it0 < NITEMS; it0 += NGW) {
        int r = __builtin_amdgcn_readfirstlane(it0);
        if (r < I_META) { p0_meta_item(F, r); continue; } r -= I_META;
        if (r < I_ROWS) { p0_rows_item(F, r); continue; } r -= I_ROWS;
        if (r < I_IN) { const int kb = r / 80, nb = r % 80; p0_transpose_item(F.w_in, DIN, 32 * nb, F.g_mix, F.Wt_in, D, 32 * nb, scr, 64 * kb, F.lane); continue; } r -= I_IN;
        if (r < I_OUT) { const int kb = r / 32, nb = r % 32; p0_transpose_item(F.w_out, D, 32 * nb, nullptr, F.Wt_out, D, 32 * nb, scr, 64 * kb, F.lane); continue; } r -= I_OUT;
        if (r < I_G) { const int kb = r / 88, nb = r % 88, n0 = 32 * nb; p0_transpose_item(F.w_fg, DFF, n0, F.g_ffn, F.Wt_gu, D, 256 * (n0 >> 7) + (n0 & 127), scr, 64 * kb, F.lane); continue; } r -= I_G;
        if (r < I_U) { const int kb = r / 88, nb = r % 88, n0 = 32 * nb; p0_transpose_item(F.w_fu, DFF, n0, F.g_ffn, F.Wt_gu, D, 256 * (n0 >> 7) + 128 + (n0 & 127), scr, 64 * kb, F.lane); continue; } r -= I_U;
        { const int kb = r / 32, nb = r % 32; p0_transpose_item(F.w_fd, D, 32 * nb, nullptr, F.Wt_dn, DFF, 32 * nb, scr, 64 * kb, F.lane); }
    }
}

constexpr int CV_RED = 0, CV_TOT = 2048;
__device__ __forceinline__ void conv_item(Frame& F, int item) {
    const int b = item >> 6, t0 = (item & 63) * 32, c = F.tid;
    float vin[62];
    if (t0 == 0) {
#pragma unroll
        for (int s = 0; s < 14; ++s) vin[s] = 0.f;
#pragma unroll
        for (int s = 14; s < 30; ++s) { const float* um = F.umeta + (size_t)(s - 14) * DIN; vin[s] = um[OFF_CV + c] * sigmoidf_(um[OFF_CG + c]); }
#pragma unroll
        for (int s = 30; s < 62; ++s) { const bf16* ur = F.u + (size_t)(b * SEQ + s - 30) * NU; vin[s] = bf2f(ur[OFF_CV + c]) * sigmoidf_(bf2f(ur[OFF_CG + c])); }
    } else {
#pragma unroll
        for (int s = 0; s < 62; ++s) { const bf16* ur = F.u + (size_t)(b * SEQ + t0 - 30 + s) * NU; vin[s] = bf2f(ur[OFF_CV + c]) * sigmoidf_(bf2f(ur[OFF_CG + c])); }
    }
    float cw[31];
#pragma unroll
    for (int w = 0; w < 31; ++w) cw[w] = F.conv_w[w * CC + c];
    const float cb = F.conv_b[c];
    float vals[64];
#pragma unroll
    for (int t = 0; t < 32; ++t) { float a = cb;
#pragma unroll
        for (int w = 0; w < 31; ++w) a += vin[t + w] * cw[w];
        vals[t] = a; vals[32 + t] = a * a; }
    float r32[32], r16[16], r8[8], r4[4], r2[2], r1;
    const int lane = F.lane;
#pragma unroll
    for (int i = 0; i < 32; ++i) { const bool up = lane & 32; const float keep = up ? vals[i + 32] : vals[i], send = up ? vals[i] : vals[i + 32]; r32[i] = keep + __shfl_xor(send, 32); }
#pragma unroll
    for (int i = 0; i < 16; ++i) { const bool up = lane & 16; const float keep = up ? r32[i + 16] : r32[i], send = up ? r32[i] : r32[i + 16]; r16[i] = keep + __shfl_xor(send, 16); }
#pragma unroll
    for (int i = 0; i < 8; ++i) { const bool up = lane & 8; const float keep = up ? r16[i + 8] : r16[i], send = up ? r16[i] : r16[i + 8]; r8[i] = keep + __shfl_xor(send, 8); }
#pragma unroll
    for (int i = 0; i < 4; ++i) { const bool up = lane & 4; const float keep = up ? r8[i + 4] : r8[i], send = up ? r8[i] : r8[i + 4]; r4[i] = keep + __shfl_xor(send, 4); }
#pragma unroll
    for (int i = 0; i < 2; ++i) { const bool up = lane & 2; const float keep = up ? r4[i + 2] : r4[i], send = up ? r4[i] : r4[i + 2]; r2[i] = keep + __shfl_xor(send, 2); }
    { const bool up = lane & 1; const float keep = up ? r2[1] : r2[0], send = up ? r2[0] : r2[1]; r1 = keep + __shfl_xor(send, 1); }
    LAS float* red = (LAS float*)(F.lds + CV_RED); LAS float* tot = (LAS float*)(F.lds + CV_TOT);
    red[F.wave * 64 + lane] = r1;
    __syncthreads();
    if (F.tid < 64) { float s = 0.f;
#pragma unroll
        for (int w = 0; w < 8; ++w) s += red[w * 64 + F.tid];
        tot[F.tid] = s; }
    __syncthreads();
    const float lg = F.cln_g[c], lb = F.cln_b[c];
    bf16* yr = F.y + (size_t)(b * SEQ + t0) * D + c;
#pragma unroll
    for (int t = 0; t < 32; ++t) { const float mean = tot[t] * (1.0f / CC); float var = tot[32 + t] * (1.0f / CC) - mean * mean; var = var > 0.f ? var : 0.f;
        const float yn = (vals[t] - mean) * __builtin_amdgcn_rsqf(var + LNC_EPS) * lg + lb; yr[(size_t)t * D] = (bf16)f2bf(siluf_(yn)); }
}

constexpr int LQ = 72;
constexpr int G_QIN = 0, G_KIN = 9216, G_KDT = 18432, G_PM = 27648, G_VT = 36864, G_ST0 = 55296, G_ST1 = 73728, G_GLRS = 92160, G_SEG = 96256, G_DEC = 98304, G_SSQ = 98560, G_END = 100608;
static_assert(G_END <= LDS_BYTES, "GLA LDS");
__device__ __forceinline__ bf16x8 ldfrag(const LAS bf16* base, int row, int col) { return *(const LAS bf16x8*)(base + row * LQ + col); }
__device__ __forceinline__ void gla_chain(Frame& F, int bh) {
    const int b = bh >> 2, h = bh & 3, tid = F.tid, lane = F.lane, w = F.wave, lo = lane & 15, hi = lane >> 4;
    LAS bf16* QIN = (LAS bf16*)(F.lds + G_QIN); LAS bf16* KIN = (LAS bf16*)(F.lds + G_KIN); LAS bf16* KDT = (LAS bf16*)(F.lds + G_KDT); LAS bf16* PM = (LAS bf16*)(F.lds + G_PM);
    LAS bf16* VT = (LAS bf16*)(F.lds + G_VT); LAS float* GLRS = (LAS float*)(F.lds + G_GLRS); LAS float* SEG = (LAS float*)(F.lds + G_SEG);
    LAS float* DEC = (LAS float*)(F.lds + G_DEC); LAS float* SSQ = (LAS float*)(F.lds + G_SSQ);
    const int d = lane, seg = w;
    float w2[16];
#pragma unroll
    for (int r = 0; r < 16; ++r) w2[r] = F.w_gate2[r * 256 + h * 64 + d];
    const float gbv = F.gate_b[h * 64 + d];
    float ng[4];
#pragma unroll
    for (int x = 0; x < 4; ++x) ng[x] = F.gnorm_g[16 * w + 4 * hi + x];
    f32x4 Sacc[4];
#pragma unroll
    for (int i = 0; i < 4; ++i) Sacc[i] = (f32x4){0.f, 0.f, 0.f, 0.f};
    for (int n = 0; n <= 32; ++n) {
        const int cur = n & 1;
        LAS bf16* STc = (LAS bf16*)(F.lds + (cur ? G_ST1 : G_ST0)); LAS bf16* STn = (LAS bf16*)(F.lds + (cur ? G_ST0 : G_ST1));
        const size_t rowbase = (size_t)b * SEQ + (size_t)(n - 1) * 64;
        float qv[8], kv[8];
        if (n == 0) {
#pragma unroll
            for (int tt = 0; tt < 8; ++tt) { qv[tt] = 0.f; kv[tt] = 0.f; }
            if (seg >= 6) {
#pragma unroll
                for (int tt = 0; tt < 8; ++tt) { const float* um = F.umeta + (size_t)(8 * (seg - 6) + tt) * DIN; qv[tt] = um[OFF_Q + h * 64 + d]; kv[tt] = um[OFF_K + h * 64 + d]; }
            }
#pragma unroll
            for (int k2 = 0; k2 < 2; ++k2) { const int idx = tid + k2 * NTHR, t = idx >> 4, r = idx & 15; GLRS[idx] = t < 48 ? 0.f : F.umeta[(size_t)(t - 48) * DIN + OFF_LR + r]; }
            { const int j = tid & 63, eb = tid >> 6;
#pragma unroll
              for (int x = 0; x < 16; ++x) { const float v = j < 48 ? 0.f : F.umeta[(size_t)(j - 48) * DIN + OFF_V + h * 128 + 16 * eb + x]; VT[(16 * eb + x) * LQ + j] = (bf16)f2bf(v); } }
        } else {
#pragma unroll
            for (int tt = 0; tt < 8; ++tt) { const bf16* ur = F.u + (rowbase + 8 * seg + tt) * NU; qv[tt] = bf2f(ur[OFF_Q + h * 64 + d]); kv[tt] = bf2f(ur[OFF_K + h * 64 + d]); }
#pragma unroll
            for (int k2 = 0; k2 < 2; ++k2) { const int idx = tid + k2 * NTHR; GLRS[idx] = F.glr[rowbase * RANK + idx]; }
            { const int j = tid & 63, eb = tid >> 6; const v4u* vp = (const v4u*)(F.u + (rowbase + j) * NU + OFF_V + h * 128 + 16 * eb); const v4u v0 = vp[0], v1 = vp[1];
              const unsigned ww[8] = {v0.x, v0.y, v0.z, v0.w, v1.x, v1.y, v1.z, v1.w};
#pragma unroll
              for (int x = 0; x < 8; ++x) { VT[(16 * eb + 2 * x) * LQ + j] = (bf16)(ww[x] & 0xffffu); VT[(16 * eb + 2 * x + 1) * LQ + j] = (bf16)(ww[x] >> 16); } }
        }
        __syncthreads();
        float la[8];
#pragma unroll
        for (int tt = 0; tt < 8; ++tt) { const int t = 8 * seg + tt; float pre = gbv;
#pragma unroll
            for (int r4 = 0; r4 < 4; ++r4) { const f32x4 g4 = *(const LAS f32x4*)(GLRS + t * 16 + 4 * r4); pre += g4[0] * w2[4 * r4] + g4[1] * w2[4 * r4 + 1] + g4[2] * w2[4 * r4 + 2] + g4[3] * w2[4 * r4 + 3]; }
            float ls = fminf(pre, 0.f) - __logf(1.0f + __expf(-fabsf(pre)));
            la[tt] = (n == 0 && t < 48) ? 0.f : ls * (1.0f / 16.0f); }
#pragma unroll
        for (int tt = 1; tt < 8; ++tt) la[tt] += la[tt - 1];
        SEG[seg * 64 + d] = la[7];
        __syncthreads();
        float off = 0.f, tot = 0.f;
#pragma unroll
        for (int s = 0; s < 8; ++s) { const float v = SEG[s * 64 + d]; tot += v; off += (s < seg) ? v : 0.f; }
        { unsigned kd[8];
#pragma unroll
          for (int tt = 0; tt < 8; ++tt) { const int t = 8 * seg + tt; const float bc = off + la[tt];
              QIN[t * LQ + d] = (bf16)f2bf(qv[tt] * 0.125f * __expf(bc)); KIN[t * LQ + d] = (bf16)f2bf(kv[tt] * __expf(-bc)); kd[tt] = f2bf(kv[tt] * __expf(tot - bc)); }
          v4u o; o.x = kd[0] | (kd[1] << 16); o.y = kd[2] | (kd[3] << 16); o.z = kd[4] | (kd[5] << 16); o.w = kd[6] | (kd[7] << 16);
          *(LAS v4u*)(KDT + d * LQ + 8 * seg) = o; }
        if (seg == 0) DEC[d] = __expf(tot);
        __syncthreads();
        if (n > 0) {
            const int it = w >> 1;
#pragma unroll
            for (int jj = 0; jj < 2; ++jj) { const int jt = 2 * (w & 1) + jj; f32x4 acc = {0.f, 0.f, 0.f, 0.f};
                if (jt <= it) {
#pragma unroll
                    for (int ks = 0; ks < 2; ++ks) acc = __builtin_amdgcn_mfma_f32_16x16x32_bf16(ldfrag(KIN, 16 * jt + lo, 32 * ks + 8 * hi), ldfrag(QIN, 16 * it + lo, 32 * ks + 8 * hi), acc, 0, 0, 0);
                }
                const int i = 16 * it + lo, j0 = 16 * jt + 4 * hi;
                v2u o; o.x = pk2(j0 <= i ? acc[0] : 0.f, j0 + 1 <= i ? acc[1] : 0.f); o.y = pk2(j0 + 2 <= i ? acc[2] : 0.f, j0 + 3 <= i ? acc[3] : 0.f);
                *(LAS v2u*)(PM + i * LQ + j0) = o; }
        }
        __syncthreads();
        bf16x8 vt[2];
#pragma unroll
        for (int ks = 0; ks < 2; ++ks) vt[ks] = ldfrag(VT, 16 * w + lo, 32 * ks + 8 * hi);
        f32x4 o[4];
        if (n > 0) {
            bf16x8 st[2];
#pragma unroll
            for (int ks = 0; ks < 2; ++ks) st[ks] = ldfrag(STc, 16 * w + lo, 32 * ks + 8 * hi);
#pragma unroll
            for (int mt = 0; mt < 4; ++mt) { o[mt] = (f32x4){0.f, 0.f, 0.f, 0.f};
#pragma unroll
                for (int ks = 0; ks < 2; ++ks) { o[mt] = __builtin_amdgcn_mfma_f32_16x16x32_bf16(vt[ks], ldfrag(PM, 16 * mt + lo, 32 * ks + 8 * hi), o[mt], 0, 0, 0);
                    o[mt] = __builtin_amdgcn_mfma_f32_16x16x32_bf16(st[ks], ldfrag(QIN, 16 * mt + lo, 32 * ks + 8 * hi), o[mt], 0, 0, 0); }
                float s = (o[mt][0] * o[mt][0] + o[mt][1] * o[mt][1]) + (o[mt][2] * o[mt][2] + o[mt][3] * o[mt][3]);
                s += __shfl_xor(s, 16); s += __shfl_xor(s, 32);
                if (hi == 0) SSQ[w * 64 + 16 * mt + lo] = s; }
        }
#pragma unroll
        for (int dt = 0; dt < 4; ++dt) { const f32x4 dc = *(const LAS f32x4*)(DEC + 16 * dt + 4 * hi); Sacc[dt] = Sacc[dt] * dc;
#pragma unroll
            for (int ks = 0; ks < 2; ++ks) Sacc[dt] = __builtin_amdgcn_mfma_f32_16x16x32_bf16(ldfrag(KDT, 16 * dt + lo, 32 * ks + 8 * hi), vt[ks], Sacc[dt], 0, 0, 0);
            v2u so; so.x = pk2(Sacc[dt][0], Sacc[dt][1]); so.y = pk2(Sacc[dt][2], Sacc[dt][3]);
            *(LAS v2u*)(STn + (16 * w + lo) * LQ + 16 * dt + 4 * hi) = so; }
        __syncthreads();
        if (n > 0) {
#pragma unroll
            for (int mt = 0; mt < 4; ++mt) { const int i = 16 * mt + lo; float tq = 0.f;
#pragma unroll
                for (int ww = 0; ww < 8; ++ww) tq += SSQ[ww * 64 + i];
                const float rn = __builtin_amdgcn_rsqf(tq * (1.0f / DV) + RMS_EPS);
                const size_t row = rowbase + i; const int e0 = 16 * w + 4 * hi;
                const v2u gw_ = *(const v2u*)(F.u + row * NU + OFF_G + h * 128 + e0);
                const float g0 = bflo(gw_.x), g1 = bfhi(gw_.x), g2 = bflo(gw_.y), g3 = bfhi(gw_.y);
                v2u yo; yo.x = pk2(o[mt][0] * rn * ng[0] * siluf_(g0), o[mt][1] * rn * ng[1] * siluf_(g1)); yo.y = pk2(o[mt][2] * rn * ng[2] * siluf_(g2), o[mt][3] * rn * ng[3] * siluf_(g3));
                *(v2u*)(F.y + row * D + CC + h * 128 + e0) = yo; }
        }
    }
}

__device__ __forceinline__ void p6_final(Frame& F) {
    const int gw = F.bid * NWAVES + F.wave, NGW = F.G * NWAVES;
    f32x4 g4[4];
#pragma unroll
    for (int j = 0; j < 4; ++j) g4[j] = *((const f32x4*)F.g_fin + F.lane + 64 * j);
    for (int m = gw; m < M; m += NGW) { const float rs = __builtin_amdgcn_rsqf(F.sq3[m] * (1.0f / D) + RMS_EPS); f32x4* o = (f32x4*)(F.out + (size_t)m * D) + F.lane;
#pragma unroll
        for (int j = 0; j < 4; ++j) o[64 * j] = o[64 * j] * rs * g4[j]; }
}

struct Args { const float* in[17]; float* out; unsigned char* ws; int ph_lo, ph_hi; };
static_assert(sizeof(Args) == 19 * 8 + 8, "Args has no padding");
__global__ void __launch_bounds__(NTHR) fwd_kernel(Args a) {
    extern __shared__ __attribute__((aligned(16))) unsigned char lds_raw[];
    cg::grid_group grid = cg::this_grid();
    Frame F;
    F.lds = (LAS unsigned char*)lds_raw;
    F.tid = threadIdx.x; F.lane = F.tid & 63; F.wave = __builtin_amdgcn_readfirstlane(F.tid >> 6); F.G = gridDim.x; F.bid = blockIdx.x;
    F.x = a.in[0]; F.meta = a.in[1]; F.g_mix = a.in[2]; F.w_in = a.in[3]; F.conv_w = a.in[4]; F.conv_b = a.in[5]; F.cln_g = a.in[6]; F.cln_b = a.in[7];
    F.w_gate2 = a.in[8]; F.gate_b = a.in[9]; F.gnorm_g = a.in[10]; F.w_out = a.in[11]; F.g_ffn = a.in[12]; F.w_fg = a.in[13]; F.w_fu = a.in[14]; F.w_fd = a.in[15]; F.g_fin = a.in[16];
    F.out = a.out;
    unsigned char* ws = a.ws;
    F.rstd1 = (float*)(ws + WS_RSTD1); F.sq2 = (float*)(ws + WS_SQ2); F.sq3 = (float*)(ws + WS_SQ3); F.umeta = (float*)(ws + WS_UMETA); F.glr = (float*)(ws + WS_GLR); F.h2 = (float*)(ws + WS_H2);
    F.Wt_in = (bf16*)(ws + WS_WIN); F.Wt_out = (bf16*)(ws + WS_WOUT); F.Wt_gu = (bf16*)(ws + WS_WGU); F.Wt_dn = (bf16*)(ws + WS_WDN);
    F.hb = (bf16*)(ws + WS_HB); F.u = (bf16*)(ws + WS_U); F.y = (bf16*)(ws + WS_Y); F.act = (bf16*)(ws + WS_ACT);
    const int lo = a.ph_lo, hi = a.ph_hi;
#define IN(k) (lo <= (k) && (k) < hi)
#define SEAM(k) do { if (IN(k) && IN((k) + 1)) grid.sync(); } while (0)
    if (IN(0)) { p0_prep(F); __syncthreads(); }
    SEAM(0);
    if (IN(1)) { pg8::Gemm g{F.hb, F.Wt_in, M, NU, D}; pg8::StaticOrder S; S.init(M, NU, F.G, F.bid); pg8::EpiU E{F.u, F.rstd1};
        pg8::gemm_phase<pg8::EpiU, pg8::StaticOrder, true, true>(F.lds, g, S, E); }
    SEAM(1);
    if (IN(2)) {
        if (F.G > 64) { if (F.bid < 64) gla_chain(F, F.bid); else for (int it = F.bid - 64; it < NB * 64; it += F.G - 64) conv_item(F, it); }
        else { for (int it = F.bid; it < 64; it += F.G) gla_chain(F, it); __syncthreads(); for (int it = F.bid; it < NB * 64; it += F.G) conv_item(F, it); }
        __syncthreads();
    }
    SEAM(2);
    if (IN(3)) { pg8::Gemm g{F.y, F.Wt_out, M, D, D}; pg8::StaticOrder S; S.init(M, D, F.G, F.bid); pg8::EpiRes<true> E{F.x, F.h2, F.hb, F.sq2};
        pg8::gemm_phase<pg8::EpiRes<true>, pg8::StaticOrder, true, true>(F.lds, g, S, E); }
    SEAM(3);
    if (IN(4)) { pg8::Gemm g{F.hb, F.Wt_gu, M, 2 * DFF, D}; pg8::StaticOrder S; S.init(M, 2 * DFF, F.G, F.bid); pg8::EpiAct E{F.act, F.sq2};
        pg8::gemm_phase<pg8::EpiAct, pg8::StaticOrder, true, true>(F.lds, g, S, E); }
    SEAM(4);
    if (IN(5)) { pg8::Gemm g{F.act, F.Wt_dn, M, D, DFF}; pg8::StaticOrder S; S.init(M, D, F.G, F.bid); pg8::EpiRes<false> E{F.h2, F.out, nullptr, F.sq3};
        pg8::gemm_phase<pg8::EpiRes<false>, pg8::StaticOrder, true, true>(F.lds, g, S, E); }
    SEAM(5);
    if (IN(6)) p6_final(F);
#undef IN
#undef SEAM
}

extern "C" void kernel_launch(void* const* d_in, const int* in_sizes, int n_in, void* d_out, int out_size, void* d_ws, size_t ws_size, hipStream_t stream) {
    static int grid = 0;
    if (grid == 0) {
        if (n_in != 17 || in_sizes[0] != M * D || out_size != M * D || ws_size < WS_END) { fprintf(stderr, "kernel_launch: unexpected shapes (n_in %d in0 %d out %d ws %zu)\n", n_in, n_in > 0 ? in_sizes[0] : -1, out_size, ws_size); grid = -1; return; }
        int dev = 0, cus = 0, per_cu = 0;
        if (hipGetDevice(&dev) != hipSuccess || hipDeviceGetAttribute(&cus, hipDeviceAttributeMultiprocessorCount, dev) != hipSuccess) { grid = -1; return; }
        if (hipFuncSetAttribute((const void*)fwd_kernel, hipFuncAttributeMaxDynamicSharedMemorySize, LDS_BYTES) != hipSuccess) { fprintf(stderr, "kernel_launch: hipFuncSetAttribute failed\n"); grid = -1; return; }
        if (hipOccupancyMaxActiveBlocksPerMultiprocessor(&per_cu, (const void*)fwd_kernel, NTHR, LDS_BYTES) != hipSuccess || per_cu < 1) { fprintf(stderr, "kernel_launch: occupancy query says %d blocks per CU\n", per_cu); (void)hipGetLastError(); per_cu = 1; }
        grid = cus * 1;
        fprintf(stderr, "kernel_launch: grid %d (cus %d, per_cu %d)\n", grid, cus, per_cu);
    }
    if (grid < 0) return;
    Args a{};
    for (int i = 0; i < 17; ++i) a.in[i] = (const float*)d_in[i];
    a.out = (float*)d_out; a.ws = (unsigned char*)d_ws;
#if MK_N_LAUNCHES == 1
    a.ph_lo = 0; a.ph_hi = N_PHASES;
    { void* args[] = {&a}; hipError_t e = hipLaunchCooperativeKernel((const void*)fwd_kernel, dim3(grid), dim3(NTHR), args, LDS_BYTES, stream);
      if (e != hipSuccess) fprintf(stderr, "kernel_launch: cooperative launch failed: %s\n", hipGetErrorString(e)); }
#else
    for (int p = 0; p < N_PHASES; ++p) { a.ph_lo = p; a.ph_hi = p + 1; void* args[] = {&a};
        hipError_t e = hipLaunchCooperativeKernel((const void*)fwd_kernel, dim3(grid), dim3(NTHR), args, LDS_BYTES, stream);
        if (e != hipSuccess) { fprintf(stderr, "kernel_launch: launch %d failed: %s\n", p, hipGetErrorString(e)); break; } }
#endif
}
```

```cpp
#include <hip/hip_runtime.h>
#include <hip/hip_cooperative_groups.h>
#include <cstdio>
#include <cstdint>
namespace cg = cooperative_groups;
namespace pg8 {
#define PG8_LAS __attribute__((address_space(3)))
typedef unsigned short bf16_t;
typedef short bf16x8 __attribute__((ext_vector_type(8)));
typedef float f32x4 __attribute__((ext_vector_type(4)));
typedef unsigned u32x4 __attribute__((ext_vector_type(4)));
typedef unsigned u32x2 __attribute__((ext_vector_type(2)));
constexpr int BM = 256, BK = 64, HALF = 128, HTB = HALF * BK * 2  , STAGE_BYTES = 8 * HTB, NXCD = 8, WGM = 8;

__host__ __device__ __forceinline__ int lds_byte(int r, int c) { const int st = (r >> 4) * 2 + (c >> 5), rr = r & 15, cc = c & 31, ob = rr * 64 + cc * 2; return st * 1024 + (ob ^ (((ob >> 9) & 1) << 5)); }
__host__ __device__ __forceinline__ void stage_rc(int b, int& R, int& C) { const int st = b / 1024, sb = b % 1024, swz = sb ^ (((sb >> 9) & 1) << 5); R = (st >> 1) * 16 + swz / 64; C = (st & 1) * 32 + (swz % 64) / 2; }
__host__ __device__ __forceinline__ int perm32(int rho) { const int n = rho >> 4, i = rho & 15; return 8 * (i >> 2) + 4 * n + (i & 3); }

struct Unit { int pm, pn; };
struct Gemm { const bf16_t* A; const bf16_t* Bt; int M, N, K; };

struct StaticOrder {
    int nM, nN, nwg, G, c;
    __host__ __device__ void init(int M, int N, int G_, int c_) { nM = M / BM; nN = N / BM; nwg = nM * nN; G = G_; c = c_; }
    __host__ __device__ bool next(int i, Unit& u) const {
        const long L = (long)i * G + c; if (L >= nwg) return false;
        int wgid = (int)L; { const int q = nwg / NXCD, r = nwg % NXCD, xcd = wgid % NXCD, off = wgid / NXCD; wgid = (xcd < r ? xcd * (q + 1) : r * (q + 1) + (xcd - r) * q) + off; }
        const int nig = WGM * nN, gid = wgid / nig, fm = gid * WGM, gsz = (nM - fm) < WGM ? (nM - fm) : WGM;
        u.pm = fm + ((wgid % nig) % gsz); u.pn = (wgid % nig) / gsz; return true;
    }
    __device__ __forceinline__ void a_ready(const Unit&) const {}
    __device__ __forceinline__ void done(const Unit&) const {}
};
__device__ __forceinline__ unsigned cvt_pk_bf16(float lo, float hi) { unsigned r; asm volatile("v_cvt_pk_bf16_f32 %0, %1, %2" : "=v"(r) : "v"(lo), "v"(hi)); return r; }
typedef float f32x2 __attribute__((ext_vector_type(2)));
template <class Epi, class Sched, bool ALIGN_EPI = false, bool SP2 = false>
__device__ __forceinline__ void gemm_phase(PG8_LAS unsigned char* lds, const Gemm g, const Sched& S, const Epi& E) {
    const int tid = threadIdx.x, wid = __builtin_amdgcn_readfirstlane(tid >> 6), lane = tid & 63, wr = wid >> 2, wc = wid & 3, fr = lane & 15, fq = lane >> 4;
    const int K = g.K, nt = K / BK;
    unsigned voffA[2], voffB[2];
#pragma unroll
    for (int i = 0; i < 2; ++i) { int R, C; stage_rc(tid * 16 + i * 8192, R, C); const int Rb = Epi::PERM ? ((R & ~31) + perm32(R & 31)) : R;
        voffA[i] = (unsigned)(R * K + C) * 2u; voffB[i] = (unsigned)(Rb * K + C) * 2u; }
    const size_t kstep = (size_t)(BK * 2);
    const size_t hstep = (size_t)HALF * K * 2;
    const size_t tstep = 2 * hstep;
    const unsigned ldsw = (unsigned)wid * 1024u;
    const int aoff = lds_byte(wr * 64 + fr, fq * 8), boff = lds_byte(wc * 32 + fr, fq * 8);
#define PG8_SA(b, h) (((b) * 2 + (h)) * HTB)
#define PG8_SB(b, h) ((4 + (b) * 2 + (h)) * HTB)
#define PG8_STAGE(bufoff, gbase, voff) do { _Pragma("unroll") for (int _i = 0; _i < 2; ++_i) \
        __builtin_amdgcn_global_load_lds((const unsigned*)((const char*)(gbase) + (voff)[_i]), (PG8_LAS unsigned*)(lds + (bufoff) + ldsw + _i * 8192), 16, 0, 0); } while (0)
#define PG8_LDA(dst, b, h) do { _Pragma("unroll") for (int m = 0; m < 4; ++m) _Pragma("unroll") for (int k = 0; k < 2; ++k) dst[m][k] = *(const PG8_LAS bf16x8*)(lds + PG8_SA(b, h) + aoff + m * 2048 + k * 1024); } while (0)
#define PG8_LDB(dst, b, h) do { _Pragma("unroll") for (int n = 0; n < 2; ++n) _Pragma("unroll") for (int k = 0; k < 2; ++k) dst[n][k] = *(const PG8_LAS bf16x8*)(lds + PG8_SB(b, h) + boff + n * 2048 + k * 1024); } while (0)
#define PG8_MMA(ai, bj, At, Bt) do { __builtin_amdgcn_s_setprio(1); _Pragma("unroll") for (int m = 0; m < 4; ++m) _Pragma("unroll") for (int n = 0; n < 2; ++n) _Pragma("unroll") for (int k = 0; k < 2; ++k) \
        acc[ai][bj][m][n] = __builtin_amdgcn_mfma_f32_16x16x32_bf16(Bt[n][k], At[m][k], acc[ai][bj][m][n], 0, 0, 0); __builtin_amdgcn_s_setprio(0); } while (0)
#define PG8_WAIT_V(n) asm volatile("s_waitcnt vmcnt(" #n ")" ::: "memory")
#define PG8_WAIT_L(n) asm volatile("s_waitcnt lgkmcnt(" #n ")" ::: "memory")
#define PG8_BAR __builtin_amdgcn_s_barrier()
#define PG8_SCHED __builtin_amdgcn_sched_barrier(0)
    Unit cur, nxt; int ui = 0;
    if (!S.next(0, cur)) return;
    f32x4 acc[2][2][4][2];
#pragma unroll
    for (int a = 0; a < 2; ++a)
#pragma unroll
        for (int b = 0; b < 2; ++b)
#pragma unroll
            for (int m = 0; m < 4; ++m)
#pragma unroll
                for (int n = 0; n < 2; ++n) acc[a][b][m][n] = (f32x4){0.f, 0.f, 0.f, 0.f};
    bf16x8 At[4][2], B0[2][2], B1[2][2];
    const char* cA = (const char*)g.A + (size_t)cur.pm * tstep; const char* cB = (const char*)g.Bt + (size_t)cur.pn * tstep;
    S.a_ready(cur);
    if constexpr (SP2) {
        PG8_STAGE(PG8_SB(0, 0), cB, voffB); PG8_STAGE(PG8_SB(0, 1), cB + hstep, voffB); PG8_STAGE(PG8_SA(0, 0), cA, voffA); PG8_STAGE(PG8_SA(0, 1), cA + hstep, voffA);
        if (wr == 1) PG8_BAR;
        PG8_WAIT_V(2); PG8_BAR;
        PG8_STAGE(PG8_SB(1, 0), cB + kstep, voffB); PG8_STAGE(PG8_SA(1, 0), cA + kstep, voffA); PG8_STAGE(PG8_SB(1, 1), cB + hstep + kstep, voffB);
        PG8_WAIT_V(6); PG8_BAR;
    } else {
        PG8_STAGE(PG8_SB(0, 0), cB, voffB); PG8_STAGE(PG8_SA(0, 0), cA, voffA); PG8_STAGE(PG8_SB(0, 1), cB + hstep, voffB); PG8_STAGE(PG8_SA(0, 1), cA + hstep, voffA);
        if (wr == 1) PG8_BAR;
        PG8_WAIT_V(4); PG8_BAR;
        PG8_STAGE(PG8_SB(1, 0), cB + kstep, voffB); PG8_STAGE(PG8_SA(1, 0), cA + kstep, voffA); PG8_STAGE(PG8_SB(1, 1), cB + hstep + kstep, voffB);
        PG8_WAIT_V(6); PG8_BAR;
    }
    for (;;) {
        const bool has_next = S.next(ui + 1, nxt);
        const char* nA = has_next ? (const char*)g.A + (size_t)nxt.pm * tstep : cA; const char* nB = has_next ? (const char*)g.Bt + (size_t)nxt.pn * tstep : cB;
        for (int t = 0; t < nt; t += 2) {
            const bool last = (t == nt - 2);
            const char* a1 = cA + (size_t)(t + 1) * kstep;
            const char* a2 = last ? nA : cA + (size_t)(t + 2) * kstep; const char* b2 = last ? nB : cB + (size_t)(t + 2) * kstep;
            const char* a3 = a2 + kstep; const char* b3 = b2 + kstep;
            if (last && has_next) S.a_ready(nxt);
            if constexpr (SP2) {
            PG8_LDB(B0, 0, 0); PG8_LDB(B1, 0, 1); PG8_SCHED; PG8_LDA(At, 0, 0); PG8_STAGE(PG8_SA(1, 1), a1 + hstep, voffA);
            PG8_WAIT_V(8); PG8_WAIT_L(0); PG8_BAR; PG8_MMA(0, 0, At, B0); PG8_MMA(0, 1, At, B1); PG8_BAR; PG8_SCHED;
            PG8_LDA(At, 0, 1); PG8_STAGE(PG8_SB(0, 0), b2, voffB); PG8_STAGE(PG8_SB(0, 1), b2 + hstep, voffB); PG8_STAGE(PG8_SA(0, 0), a2, voffA);
            PG8_WAIT_V(8); PG8_WAIT_L(0); PG8_BAR; PG8_MMA(1, 0, At, B0); PG8_MMA(1, 1, At, B1); PG8_BAR; PG8_SCHED;
            PG8_LDB(B0, 1, 0); PG8_LDB(B1, 1, 1); PG8_SCHED; PG8_LDA(At, 1, 0); PG8_STAGE(PG8_SA(0, 1), a2 + hstep, voffA);
            PG8_WAIT_V(8); PG8_WAIT_L(0); PG8_BAR; PG8_MMA(0, 0, At, B0); PG8_MMA(0, 1, At, B1); PG8_BAR; PG8_SCHED;
            PG8_LDA(At, 1, 1); PG8_STAGE(PG8_SB(1, 0), b3, voffB); PG8_STAGE(PG8_SB(1, 1), b3 + hstep, voffB); PG8_STAGE(PG8_SA(1, 0), a3, voffA);
            PG8_WAIT_V(8); PG8_WAIT_L(0); PG8_BAR; PG8_MMA(1, 0, At, B0); PG8_MMA(1, 1, At, B1); PG8_BAR; PG8_SCHED;
            } else {
            PG8_LDB(B0, 0, 0); PG8_SCHED; PG8_LDA(At, 0, 0); PG8_STAGE(PG8_SA(1, 1), a1 + hstep, voffA);
            PG8_WAIT_L(8); PG8_BAR; PG8_WAIT_L(0); PG8_MMA(0, 0, At, B0); PG8_BAR; PG8_SCHED;
            PG8_LDB(B1, 0, 1); PG8_STAGE(PG8_SB(0, 0), b2, voffB);
            PG8_BAR; PG8_WAIT_L(0); PG8_MMA(0, 1, At, B1); PG8_BAR;
            PG8_LDA(At, 0, 1); PG8_STAGE(PG8_SA(0, 0), a2, voffA);
            PG8_BAR; PG8_WAIT_L(0); PG8_MMA(1, 0, At, B0); PG8_BAR; PG8_SCHED;
            PG8_STAGE(PG8_SB(0, 1), b2 + hstep, voffB);
            PG8_WAIT_V(6); PG8_BAR; PG8_MMA(1, 1, At, B1); PG8_BAR;
            PG8_LDB(B0, 1, 0); PG8_SCHED; PG8_LDA(At, 1, 0); PG8_STAGE(PG8_SA(0, 1), a2 + hstep, voffA);
            PG8_WAIT_L(8); PG8_BAR; PG8_WAIT_L(0); PG8_MMA(0, 0, At, B0); PG8_BAR; PG8_SCHED;
            PG8_LDB(B1, 1, 1); PG8_STAGE(PG8_SB(1, 0), b3, voffB);
            PG8_BAR; PG8_WAIT_L(0); PG8_MMA(0, 1, At, B1); PG8_BAR;
            PG8_LDA(At, 1, 1); PG8_STAGE(PG8_SA(1, 0), a3, voffA);
            PG8_BAR; PG8_WAIT_L(0); PG8_MMA(1, 0, At, B0); PG8_BAR; PG8_SCHED;
            PG8_STAGE(PG8_SB(1, 1), b3 + hstep, voffB);
            PG8_WAIT_V(6); PG8_BAR; PG8_MMA(1, 1, At, B1); PG8_BAR;
            }
        }
        if constexpr (ALIGN_EPI) { if (wr == 0) PG8_BAR; }
        if constexpr (!Epi::AFTER_DRAIN) { E(acc, cur, wr, wc, fr, fq); S.done(cur); }
        if (!has_next) break;
#pragma unroll
        for (int a = 0; a < 2; ++a)
#pragma unroll
            for (int b = 0; b < 2; ++b)
#pragma unroll
                for (int m = 0; m < 4; ++m)
#pragma unroll
                    for (int n = 0; n < 2; ++n) acc[a][b][m][n] = (f32x4){0.f, 0.f, 0.f, 0.f};
        cur = nxt; cA = nA; cB = nB; ++ui;
        if constexpr (ALIGN_EPI) { if (wr == 1) PG8_BAR; }
    }
    PG8_WAIT_V(0);
    if constexpr (!ALIGN_EPI) { if (wr == 0) PG8_BAR; }
    PG8_BAR;
    if constexpr (Epi::AFTER_DRAIN) { E.fused(acc, cur, wr, wc, fr, fq, lds, wid, lane); S.done(cur); }
#undef PG8_SA
#undef PG8_SB
#undef PG8_STAGE
#undef PG8_LDA
#undef PG8_LDB
#undef PG8_MMA
#undef PG8_WAIT_V
#undef PG8_WAIT_L
#undef PG8_BAR
#undef PG8_SCHED
}
}

constexpr int NB = 16, SEQ = 2048, D = 1024, M = NB * SEQ, NMETA = 16;
constexpr int CC = 512, CWID = 31, NH = 4, DK = 64, DV = 128, RANK = 16, DFF = 2816, DIN = 2576, NU = 2560;
constexpr int OFF_CV = 0, OFF_CG = 512, OFF_Q = 1024, OFF_K = 1280, OFF_V = 1536, OFF_G = 2048, OFF_LR = 2560;
constexpr float RMS_EPS = 1e-6f, LNC_EPS = 1e-5f;
constexpr int NWAVES = 8, NTHR = 512;
#ifndef REP0
#define REP0 1
#endif
#ifndef REP1
#define REP1 1
#endif
#ifndef REP2
#define REP2 1
#endif
#ifndef REP3
#define REP3 1
#endif
#ifndef REP4
#define REP4 1
#endif
#ifndef REP5
#define REP5 1
#endif
#ifndef MK_N_LAUNCHES
#define MK_N_LAUNCHES 1
#endif
constexpr int N_PHASES = 7;

constexpr size_t MiB = 1u << 20;
constexpr size_t WS_CTL = 0, CTL_ZERO_BYTES = 65536; constexpr int CTL_CONVQ = 64, CTL_BAR = 4096;
constexpr int LDS_BAR_OFF = 147456 - 64;
constexpr size_t WS_RSTD1 = 1 * MiB, WS_SQ2 = WS_RSTD1 + 128 * 1024, WS_SQ3 = WS_SQ2 + 128 * 1024, WS_UMETA = 2 * MiB, WS_METAB = WS_UMETA + 256 * 1024, WS_WLR = WS_METAB + 32 * 1024, WS_RSTDM = WS_WLR + 32 * 1024;
constexpr size_t WS_WIN = 4 * MiB, WS_WOUT = 10 * MiB, WS_WGU = 12 * MiB, WS_WDN = 24 * MiB, WS_GLR = 30 * MiB;
constexpr size_t WS_HB = 32 * MiB;
constexpr size_t WS_U = 96 * MiB;
constexpr size_t WS_Y = 256 * MiB;
constexpr size_t WS_ACT = 96 * MiB;
constexpr size_t WS_H2 = 320 * MiB;
constexpr size_t WS_END = 448 * MiB;
constexpr int LDS_BYTES = 147456;

#define GAS __attribute__((address_space(1)))
#define LAS __attribute__((address_space(3)))
typedef unsigned short bf16;
typedef unsigned v4u __attribute__((ext_vector_type(4)));
typedef unsigned v2u __attribute__((ext_vector_type(2)));
typedef float f32x4 __attribute__((ext_vector_type(4)));
typedef short bf16x8 __attribute__((ext_vector_type(8)));
#define LDS_WAIT() asm volatile("s_waitcnt lgkmcnt(0)" ::: "memory")

__device__ __forceinline__ unsigned f2bf(float f) { unsigned u = __builtin_bit_cast(unsigned, f); return (u + 0x7fffu + ((u >> 16) & 1u)) >> 16; }
__device__ __forceinline__ unsigned pk2(float lo, float hi) { return f2bf(lo) | (f2bf(hi) << 16); }
typedef __bf16 bf16v2_t __attribute__((ext_vector_type(2)));
typedef float f32x2_t __attribute__((ext_vector_type(2)));
__device__ __forceinline__ unsigned cvt2(float a, float b) { const f32x2_t f = {a, b}; return __builtin_bit_cast(unsigned, __builtin_convertvector(f, bf16v2_t)); }
__device__ __forceinline__ float bf2f(unsigned b) { return __builtin_bit_cast(float, b << 16); }
__device__ __forceinline__ float bflo(unsigned w) { return __builtin_bit_cast(float, w << 16); }
__device__ __forceinline__ float bfhi(unsigned w) { return __builtin_bit_cast(float, w & 0xffff0000u); }
__device__ __forceinline__ float sigmoidf_(float x) { return __builtin_amdgcn_rcpf(1.0f + __expf(-x)); }
__device__ __forceinline__ float siluf_(float x) { return x * sigmoidf_(x); }
__device__ __forceinline__ float wave_sum(float v) {
#pragma unroll
    for (int o = 1; o < 64; o <<= 1) v += __shfl_xor(v, o);
    return v;
}

namespace pg8 {
struct EpiU {
    static constexpr bool PERM = true, AFTER_DRAIN = false;
    bf16_t* O; const float* rstd;
    __device__ __forceinline__ void operator()(const f32x4 (&acc)[2][2][4][2], const Unit& u, int wr, int wc, int fr, int fq) const {
        const int row0 = u.pm * BM + wr * 64 + fr, col0 = u.pn * BM + wc * 32 + 8 * fq;
#pragma unroll
        for (int ai = 0; ai < 2; ++ai)
#pragma unroll
            for (int m = 0; m < 4; ++m) { const int row = row0 + ai * HALF + m * 16; const float rs = rstd[row]; bf16_t* rowp = O + (size_t)row * NU + col0;
#pragma unroll
                for (int bj = 0; bj < 2; ++bj) { const f32x4 v0 = acc[ai][bj][m][0] * rs, v1 = acc[ai][bj][m][1] * rs;
                    u32x4 w; w.x = cvt_pk_bf16(v0[0], v0[1]); w.y = cvt_pk_bf16(v0[2], v0[3]); w.z = cvt_pk_bf16(v1[0], v1[1]); w.w = cvt_pk_bf16(v1[2], v1[3]);
                    *(u32x4*)(rowp + bj * HALF) = w; } }
    }
};
template <bool WITH_BF16> struct EpiRes {
    static constexpr bool PERM = false, AFTER_DRAIN = false;
    const float* base; float* out; bf16_t* ob; float* sq;
    __device__ __forceinline__ void operator()(const f32x4 (&acc)[2][2][4][2], const Unit& u, int wr, int wc, int fr, int fq) const {
        const int row0 = u.pm * BM + wr * 64 + fr, col0 = u.pn * BM + wc * 32 + 4 * fq;
#pragma unroll
        for (int ai = 0; ai < 2; ++ai)
#pragma unroll
            for (int m = 0; m < 4; ++m) { const int row = row0 + ai * HALF + m * 16; const size_t off = (size_t)row * D + col0; float ss = 0.f;
#pragma unroll
                for (int bj = 0; bj < 2; ++bj)
#pragma unroll
                    for (int n = 0; n < 2; ++n) { const f32x4 bs = *(const f32x4*)(base + off + bj * HALF + n * 16); const f32x4 h = bs + acc[ai][bj][m][n];
                        *(f32x4*)(out + off + bj * HALF + n * 16) = h;
                        if (WITH_BF16) { u32x2 w; w.x = cvt_pk_bf16(h[0], h[1]); w.y = cvt_pk_bf16(h[2], h[3]); *(u32x2*)(ob + off + bj * HALF + n * 16) = w; }
                        ss += (h[0] * h[0] + h[1] * h[1]) + (h[2] * h[2] + h[3] * h[3]); }
                ss += __shfl_xor(ss, 16); ss += __shfl_xor(ss, 32);
                if (fq == 0) atomicAdd(sq + row, ss);
                asm volatile("" ::: "memory"); }
    }
};
struct EpiAct {
    static constexpr bool PERM = true, AFTER_DRAIN = false;
    bf16_t* O; const float* sq;
    __device__ __forceinline__ void operator()(const f32x4 (&acc)[2][2][4][2], const Unit& u, int wr, int wc, int fr, int fq) const {
        const int row0 = u.pm * BM + wr * 64 + fr, col0 = u.pn * HALF + wc * 32 + 8 * fq;
#pragma unroll
        for (int ai = 0; ai < 2; ++ai)
#pragma unroll
            for (int m = 0; m < 4; ++m) { const int row = row0 + ai * HALF + m * 16; const float rs = __builtin_amdgcn_rsqf(sq[row] * (1.0f / D) + 1e-6f);
                float r[8];
#pragma unroll
                for (int n = 0; n < 2; ++n)
#pragma unroll
                    for (int j = 0; j < 4; ++j) { const float g = acc[ai][0][m][n][j] * rs, up = acc[ai][1][m][n][j] * rs; r[n * 4 + j] = g * __builtin_amdgcn_rcpf(1.0f + __expf(-g)) * up; }
                u32x4 w; w.x = cvt_pk_bf16(r[0], r[1]); w.y = cvt_pk_bf16(r[2], r[3]); w.z = cvt_pk_bf16(r[4], r[5]); w.w = cvt_pk_bf16(r[6], r[7]);
                *(u32x4*)(O + (size_t)row * DFF + col0) = w; }
    }
};
}

#define RLX_AGENT __ATOMIC_RELAXED, __HIP_MEMORY_SCOPE_AGENT
#define XB_TMO      128
#define XB_XCNT(j)  (256  + 64 * (j))
#define XB_XSUB(j)  (1280 + 64 * (j))
#define XB_XGEN(j)  (2304 + 64 * (j))
#define XB_TOP      3328
#define XB_TOPGEN   3392
#define XCD_BAR_WORDS 3456
#define XB_SPIN_CAP (1u << 18)

__device__ __forceinline__ unsigned xb_ld(unsigned* p)              { return __hip_atomic_load(p, __ATOMIC_RELAXED, __HIP_MEMORY_SCOPE_AGENT); }
__device__ __forceinline__ unsigned xb_add(unsigned* p, unsigned v) { return __hip_atomic_fetch_add(p, v, __ATOMIC_RELAXED, __HIP_MEMORY_SCOPE_AGENT); }
__device__ __forceinline__ unsigned xb_xcc_id() { return (unsigned)__builtin_amdgcn_s_getreg((3 << 11) | 20) & 0xFu; }
#define XB_SPIN(cond, bar) do { unsigned _sp = 0; while (cond) { __builtin_amdgcn_s_sleep(1); \
    if ((++_sp & 255u) == 0u) { if (xb_ld(&(bar)[XB_TMO])) break; if (_sp > XB_SPIN_CAP) { atomicAdd(&(bar)[XB_TMO], 1u); break; } } } } while (0)

struct XcdBarrier {
    unsigned* bar; unsigned x;
    volatile LAS unsigned* st;
};

__device__ __forceinline__ XcdBarrier xcd_barrier_post(unsigned* bar, volatile LAS unsigned* st) {
    XcdBarrier b; b.bar = bar; b.x = xb_xcc_id(); b.st = st;
    if (threadIdx.x == 0) (void)xb_add(&bar[XB_XCNT(b.x)], 1u);
    return b;
}
__device__ __forceinline__ void xcd_barrier_complete(unsigned* bar, unsigned x, unsigned& nloc, unsigned& nx) {
    const unsigned G = gridDim.x * gridDim.y * gridDim.z;
    unsigned sum, cnt, mine, sp = 0u;
    for (;;) {
        sum = 0u; cnt = 0u; mine = 0u;
#pragma unroll
        for (unsigned j = 0; j < 16; ++j) { const unsigned c = xb_ld(&bar[XB_XCNT(j)]); sum += c; cnt += (c > 0u) ? 1u : 0u; mine = (j == x) ? c : mine; }
        if (sum == G) break;
        __builtin_amdgcn_s_sleep(1);
        if ((++sp & 255u) == 0u) { if (xb_ld(&bar[XB_TMO])) break; if (sp > XB_SPIN_CAP) { atomicAdd(&bar[XB_TMO], 1u); break; } }
    }
    nloc = mine > 0u ? mine : 1u; nx = cnt > 0u ? cnt : 1u;
}

__device__ __forceinline__ void xcd_barrier(const XcdBarrier& b) {
    asm volatile("s_waitcnt vmcnt(0)" ::: "memory");
    __syncthreads();
    if (threadIdx.x == 0) {
        unsigned* bar = b.bar;
        __builtin_amdgcn_s_waitcnt(0);
        unsigned nloc = b.st[0], nx = b.st[1];
        if (nloc == 0u) { xcd_barrier_complete(bar, b.x, nloc, nx); b.st[0] = nloc; b.st[1] = nx; }
        const unsigned old = xb_add(&bar[XB_XSUB(b.x)], 1u);
        const unsigned gen = old / nloc;
        if (old + 1u == (gen + 1u) * nloc) {
            __builtin_amdgcn_fence(__ATOMIC_RELEASE, "agent");
            asm volatile("s_waitcnt vmcnt(0)" ::: "memory");
            const unsigned og = xb_add(&bar[XB_TOP], 1u);
            const unsigned tg = og / nx;
            if (og + 1u == (tg + 1u) * nx) xb_add(&bar[XB_TOPGEN], 1u);
            else XB_SPIN(xb_ld(&bar[XB_TOPGEN]) == tg, bar);
            __builtin_amdgcn_fence(__ATOMIC_ACQUIRE, "agent");
            xb_add(&bar[XB_XGEN(b.x)], 1u);
            asm volatile("s_waitcnt vmcnt(0)" ::: "memory");
        } else {
            XB_SPIN(xb_ld(&bar[XB_XGEN(b.x)]) == gen, bar);
            __builtin_amdgcn_fence(__ATOMIC_ACQUIRE, "agent");
            asm volatile("s_waitcnt vmcnt(0)" ::: "memory");
        }
    }
    __syncthreads();
}

struct Frame {
    LAS unsigned char* lds;
    int tid, lane, wave, G, bid;
    const float *x, *meta, *g_mix, *w_in, *conv_w, *conv_b, *cln_g, *cln_b, *w_gate2, *gate_b, *gnorm_g, *w_out, *g_ffn, *w_fg, *w_fu, *w_fd, *g_fin;
    float* out;
    float *rstd1, *sq2, *sq3, *umeta, *glr, *h2, *rstdm; unsigned* ctl; bf16 *metab, *wlr;
    bf16 *Wt_in, *Wt_out, *Wt_gu, *Wt_dn, *hb, *u, *y, *act;
};

__device__ __forceinline__ void p0_transpose_item(const float* W, int ldw, int col_off, const float* gsc, bf16* WT, int Kd, int dst_row, LAS float* scr, int k0, int lane) {
#pragma unroll 8
    for (int i = 0; i < 32; ++i) { const int kk = 2 * i + (lane >> 5); float v = W[(size_t)(k0 + kk) * ldw + col_off + (lane & 31)]; if (gsc) v *= gsc[k0 + kk]; scr[kk * 33 + (lane & 31)] = v; }
    LDS_WAIT(); asm volatile("" ::: "memory");
    const int c = lane & 7;
#pragma unroll
    for (int j = 0; j < 4; ++j) { const int n = (lane >> 3) + 8 * j; const LAS float* s = scr + (8 * c) * 33 + n;
        v4u o; o.x = pk2(s[0 * 33], s[1 * 33]); o.y = pk2(s[2 * 33], s[3 * 33]); o.z = pk2(s[4 * 33], s[5 * 33]); o.w = pk2(s[6 * 33], s[7 * 33]);
        *(v4u*)(WT + (size_t)(dst_row + n) * Kd + k0 + 8 * c) = o; }
    LDS_WAIT(); asm volatile("" ::: "memory");
}
constexpr int P0_SCR_BYTES = 8704, P0_WLR_OFF = 8 * P0_SCR_BYTES, WLR_STRIDE = 1032;
static_assert(P0_WLR_OFF + 16 * WLR_STRIDE * 2 <= LDS_BYTES, "P0 LDS");
__device__ __forceinline__ void p0_rows_item(Frame& F, int grp) {
    const int lane = F.lane, r = lane & 15, q = lane >> 4; const int row = grp * 16 + r;
    const float* xr = F.x + (size_t)row * D + 16 * q; bf16* hr = F.hb + (size_t)row * D + 16 * q;
    const LAS bf16* wl = (const LAS bf16*)(F.lds + P0_WLR_OFF) + r * WLR_STRIDE + 16 * q;
    f32x4 acc = {0.f, 0.f, 0.f, 0.f}; float ss = 0.f;
#pragma unroll 4
    for (int kb = 0; kb < 16; ++kb) {
        const f32x4 a0 = *(const f32x4*)(xr + kb * 64), a1 = *(const f32x4*)(xr + kb * 64 + 4), a2 = *(const f32x4*)(xr + kb * 64 + 8), a3 = *(const f32x4*)(xr + kb * 64 + 12);
        ss += (a0[0] * a0[0] + a0[1] * a0[1]) + (a0[2] * a0[2] + a0[3] * a0[3]) + (a1[0] * a1[0] + a1[1] * a1[1]) + (a1[2] * a1[2] + a1[3] * a1[3])
            + (a2[0] * a2[0] + a2[1] * a2[1]) + (a2[2] * a2[2] + a2[3] * a2[3]) + (a3[0] * a3[0] + a3[1] * a3[1]) + (a3[2] * a3[2] + a3[3] * a3[3]);
        v4u p0, p1; p0.x = pk2(a0[0], a0[1]); p0.y = pk2(a0[2], a0[3]); p0.z = pk2(a1[0], a1[1]); p0.w = pk2(a1[2], a1[3]);
        p1.x = pk2(a2[0], a2[1]); p1.y = pk2(a2[2], a2[3]); p1.z = pk2(a3[0], a3[1]); p1.w = pk2(a3[2], a3[3]);
        *(v4u*)(hr + kb * 64) = p0; *(v4u*)(hr + kb * 64 + 8) = p1;
        const bf16x8 b0 = *(const LAS bf16x8*)(wl + kb * 64), b1 = *(const LAS bf16x8*)(wl + kb * 64 + 8);
        acc = __builtin_amdgcn_mfma_f32_16x16x32_bf16(__builtin_bit_cast(bf16x8, p0), b0, acc, 0, 0, 0);
        acc = __builtin_amdgcn_mfma_f32_16x16x32_bf16(__builtin_bit_cast(bf16x8, p1), b1, acc, 0, 0, 0);
    }
    ss += __shfl_xor(ss, 16); ss += __shfl_xor(ss, 32);
    const float rs = __builtin_amdgcn_rsqf(ss * (1.0f / D) + RMS_EPS);
    if (q == 0) F.rstd1[row] = rs;
#pragma unroll
    for (int i = 0; i < 4; ++i) { const float rsi = __shfl(rs, 4 * q + i); F.glr[(size_t)(grp * 16 + 4 * q + i) * RANK + r] = acc[i] * rsi; }
}
__device__ __forceinline__ void p0_metab_item(Frame& F, int m) {
    const f32x4* xr = (const f32x4*)(F.meta + (size_t)m * D) + F.lane; float ss = 0.f;
#pragma unroll
    for (int j = 0; j < 4; ++j) { const f32x4 v = xr[64 * j]; ss += (v[0] * v[0] + v[1] * v[1]) + (v[2] * v[2] + v[3] * v[3]);
        v2u o; o.x = pk2(v[0], v[1]); o.y = pk2(v[2], v[3]); *(v2u*)(F.metab + (size_t)m * D + 4 * F.lane + 256 * j) = o; }
    const float rs = __builtin_amdgcn_rsqf(wave_sum(ss) * (1.0f / D) + RMS_EPS);
    if (F.lane == 0) F.rstdm[m] = rs;
}
__device__ __forceinline__ void p1_meta_item(Frame& F, int nt) {
    const int lo = F.lane & 15, hi = F.lane >> 4;
    const bf16* Brow = (nt < 160 ? F.Wt_in + (size_t)(16 * nt + lo) * D : F.wlr + (size_t)lo * D) + 8 * hi;
    const bf16* Arow = F.metab + (size_t)lo * D + 8 * hi;
    f32x4 acc = {0.f, 0.f, 0.f, 0.f};
#pragma unroll 8
    for (int ks = 0; ks < 32; ++ks) acc = __builtin_amdgcn_mfma_f32_16x16x32_bf16(*(const bf16x8*)(Arow + 32 * ks), *(const bf16x8*)(Brow + 32 * ks), acc, 0, 0, 0);
#pragma unroll
    for (int x = 0; x < 4; ++x) F.umeta[(size_t)(4 * hi + x) * DIN + 16 * nt + lo] = acc[x] * F.rstdm[4 * hi + x];
}
__device__ __forceinline__ void p0_prep(Frame& F) {
    if (F.bid == 0 && F.tid == 0) { F.ctl[CTL_CONVQ] = 0u; F.ctl[CTL_CONVQ + 1] = 0u; }
    for (int i = F.bid * NTHR + F.tid; i < M; i += F.G * NTHR) { F.sq2[i] = 0.f; F.sq3[i] = 0.f; }
    { LAS bf16* wl = (LAS bf16*)(F.lds + P0_WLR_OFF);
      for (int idx = F.tid; idx < RANK * D; idx += NTHR) { const int k = idx >> 4, n = idx & 15; const bf16 v = (bf16)f2bf(F.w_in[(size_t)k * DIN + OFF_LR + n] * F.g_mix[k]); wl[n * WLR_STRIDE + k] = v; if (F.bid == 0) F.wlr[(size_t)n * D + k] = v; } }
    __syncthreads();
    LAS float* scr = (LAS float*)(F.lds + F.wave * P0_SCR_BYTES);
    const int gw = F.bid * NWAVES + F.wave, NGW = F.G * NWAVES;
    constexpr int I_META = 16, I_ROWS = M / 16, I_IN = 16 * 80, I_OUT = 16 * 32, I_G = 16 * 88, I_U = I_G, I_D = 44 * 32;
    constexpr int NITEMS = I_META + I_ROWS + I_IN + I_OUT + I_G + I_U + I_D;
    for (int it0 = gw; it0 < NITEMS; it0 += NGW) {
        int r = __builtin_amdgcn_readfirstlane(it0);
        if (r < I_META) { p0_metab_item(F, r); continue; } r -= I_META;
        if (r < I_ROWS) { p0_rows_item(F, r); continue; } r -= I_ROWS;
        if (r < I_IN) { const int kb = r / 80, nb = r % 80; p0_transpose_item(F.w_in, DIN, 32 * nb, F.g_mix, F.Wt_in, D, 32 * nb, scr, 64 * kb, F.lane); continue; } r -= I_IN;
        if (r < I_OUT) { const int kb = r / 32, nb = r % 32; p0_transpose_item(F.w_out, D, 32 * nb, nullptr, F.Wt_out, D, 32 * nb, scr, 64 * kb, F.lane); continue; } r -= I_OUT;
        if (r < I_G) { const int kb = r / 88, nb = r % 88, n0 = 32 * nb; p0_transpose_item(F.w_fg, DFF, n0, F.g_ffn, F.Wt_gu, D, 256 * (n0 >> 7) + (n0 & 127), scr, 64 * kb, F.lane); continue; } r -= I_G;
        if (r < I_U) { const int kb = r / 88, nb = r % 88, n0 = 32 * nb; p0_transpose_item(F.w_fu, DFF, n0, F.g_ffn, F.Wt_gu, D, 256 * (n0 >> 7) + 128 + (n0 & 127), scr, 64 * kb, F.lane); continue; } r -= I_U;
        { const int kb = r / 32, nb = r % 32; p0_transpose_item(F.w_fd, D, 32 * nb, nullptr, F.Wt_dn, DFF, 32 * nb, scr, 64 * kb, F.lane); }
    }
}

constexpr int CV_RED = 0, CV_TOT = 2048, CV_Q = 2560, CV_TILE = 4096;
static_assert(CV_TILE + 62 * 2048 <= LDS_BYTES, "conv LDS");
__device__ __forceinline__ void conv_item(Frame& F, int item) {
    const int b = item >> 6, t0 = (item & 63) * 32, c = F.tid;
    LAS bf16* tile = (LAS bf16*)(F.lds + CV_TILE);
    if (t0 == 0) {
        for (int idx = F.tid; idx < 14 * 128; idx += NTHR) *(LAS v4u*)(tile + idx * 8) = (v4u){0u, 0u, 0u, 0u};
        for (int idx = F.tid; idx < 16 * 512; idx += NTHR) { const int m = idx >> 9, cc = (idx & 511) * 2; const float* um = F.umeta + (size_t)m * DIN + cc; *(LAS unsigned*)(tile + (14 + m) * 1024 + cc) = pk2(um[0], um[1]); }
#pragma unroll 4
        for (int idx = F.tid; idx < 32 * 128; idx += NTHR) { const int r = idx >> 7, ch = idx & 127; *(LAS v4u*)(tile + (30 + r) * 1024 + ch * 8) = *(const v4u*)(F.u + (size_t)(b * SEQ + r) * NU + ch * 8); }
    } else {
#pragma unroll 4
        for (int idx = F.tid; idx < 62 * 128; idx += NTHR) { const int r = idx >> 7, ch = idx & 127; *(LAS v4u*)(tile + r * 1024 + ch * 8) = *(const v4u*)(F.u + (size_t)(b * SEQ + t0 - 30 + r) * NU + ch * 8); }
    }
    __syncthreads();
    float cw[31];
#pragma unroll
    for (int w = 0; w < 31; ++w) cw[w] = F.conv_w[w * CC + c];
    const float cb = F.conv_b[c];
    float vals[64];
#pragma unroll
    for (int t = 0; t < 32; ++t) vals[t] = cb;
#pragma unroll
    for (int s = 0; s < 62; ++s) { const float v = bf2f(tile[s * 1024 + c]) * sigmoidf_(bf2f(tile[s * 1024 + 512 + c]));
#pragma unroll
        for (int t = 0; t < 32; ++t) if (s - t >= 0 && s - t <= 30) vals[t] += v * cw[s - t]; }
#pragma unroll
    for (int t = 0; t < 32; ++t) vals[32 + t] = vals[t] * vals[t];
    float r32[32], r16[16], r8[8], r4[4], r2[2], r1;
    const int lane = F.lane;
#pragma unroll
    for (int i = 0; i < 32; ++i) { const bool up = lane & 32; const float keep = up ? vals[i + 32] : vals[i], send = up ? vals[i] : vals[i + 32]; r32[i] = keep + __shfl_xor(send, 32); }
#pragma unroll
    for (int i = 0; i < 16; ++i) { const bool up = lane & 16; const float keep = up ? r32[i + 16] : r32[i], send = up ? r32[i] : r32[i + 16]; r16[i] = keep + __shfl_xor(send, 16); }
#pragma unroll
    for (int i = 0; i < 8; ++i) { const bool up = lane & 8; const float keep = up ? r16[i + 8] : r16[i], send = up ? r16[i] : r16[i + 8]; r8[i] = keep + __shfl_xor(send, 8); }
#pragma unroll
    for (int i = 0; i < 4; ++i) { const bool up = lane & 4; const float keep = up ? r8[i + 4] : r8[i], send = up ? r8[i] : r8[i + 4]; r4[i] = keep + __shfl_xor(send, 4); }
#pragma unroll
    for (int i = 0; i < 2; ++i) { const bool up = lane & 2; const float keep = up ? r4[i + 2] : r4[i], send = up ? r4[i] : r4[i + 2]; r2[i] = keep + __shfl_xor(send, 2); }
    { const bool up = lane & 1; const float keep = up ? r2[1] : r2[0], send = up ? r2[0] : r2[1]; r1 = keep + __shfl_xor(send, 1); }
    LAS float* red = (LAS float*)(F.lds + CV_RED); LAS float* tot = (LAS float*)(F.lds + CV_TOT);
    red[F.wave * 64 + lane] = r1;
    __syncthreads();
    if (F.tid < 64) { float s = 0.f;
#pragma unroll
        for (int w = 0; w < 8; ++w) s += red[w * 64 + F.tid];
        tot[F.tid] = s; }
    __syncthreads();
    const float lg = F.cln_g[c], lb = F.cln_b[c];
    bf16* yr = F.y + (size_t)(b * SEQ + t0) * D + c;
#pragma unroll
    for (int t = 0; t < 32; ++t) { const float mean = tot[t] * (1.0f / CC); float var = tot[32 + t] * (1.0f / CC) - mean * mean; var = var > 0.f ? var : 0.f;
        const float yn = (vals[t] - mean) * __builtin_amdgcn_rsqf(var + LNC_EPS) * lg + lb; yr[(size_t)t * D] = (bf16)f2bf(siluf_(yn)); }
}

constexpr int LQ = 72;
constexpr int G_QIN = 0, G_KIN = 9216, G_KDT = 18432, G_VT = 27648, G_ST0 = 46080, G_ST1 = 64512, G_GLRS0 = 82944, G_GLRS1 = 87040, G_SEG = 91136, G_DEC = 93184, G_NG = 93440, G_END = 93952;
static_assert(G_END <= LDS_BYTES, "GLA LDS");
#ifdef DBG_SYNC
#define GBAR() do { __syncthreads(); __syncthreads(); } while (0)
#else
#define GBAR() do { asm volatile("s_waitcnt lgkmcnt(0)" ::: "memory"); __builtin_amdgcn_s_barrier(); asm volatile("" ::: "memory"); } while (0)
#endif
__device__ __forceinline__ bf16x8 ldfrag(const LAS bf16* base, int row, int col) { return *(const LAS bf16x8*)(base + row * LQ + col); }
struct RawSet { unsigned q[8], k[8]; v2u vp[4]; };
__device__ __forceinline__ void gla_load_set(Frame& F, RawSet& R, int b, int h, int cn) {
    const int lane = F.lane, w = F.wave;
    const size_t r0 = (size_t)b * SEQ + (size_t)(cn - 1) * 64;
#pragma unroll
    for (int tt = 0; tt < 8; ++tt) { const bf16* ur = F.u + (r0 + 8 * w + tt) * NU + h * 64 + (lane & ~1); R.q[tt] = *(const unsigned*)(ur + OFF_Q); R.k[tt] = *(const unsigned*)(ur + OFF_K); }
    { const v2u* p = (const v2u*)(F.u + (r0 + (F.tid & 63)) * NU + OFF_V + h * 128 + 16 * (F.tid >> 6));
#pragma unroll
      for (int i = 0; i < 4; ++i) R.vp[i] = p[i]; }
}
__device__ __forceinline__ void gla_load_g(Frame& F, v2u (&gp)[8], int b, int h, int cn) {
    const int lane = F.lane, w = F.wave, lo = lane & 15, hi = lane >> 4;
    const bf16* gr = F.u + ((size_t)b * SEQ + (size_t)(cn - 1) * 64 + 16 * (w & 3) + lo) * NU + OFF_G + h * 128 + 4 * hi;
#pragma unroll
    for (int et = 0; et < 8; ++et) gp[et] = *(const v2u*)(gr + 16 * et);
}
__device__ __forceinline__ f32x4 gla_load_glr(Frame& F, int b, int cn) { return *(const f32x4*)(F.glr + ((size_t)b * SEQ + (size_t)(cn - 1) * 64) * RANK + (F.tid & 255) * 4); }
__device__ __forceinline__ void gla_chunk(Frame& F, const int n, const int b, const int h, RawSet& cur, RawSet& nxt, f32x4& ring, f32x4 (&acc8)[8], const float (&w2)[16], const float gbv) {
    const int tid = F.tid, lane = F.lane, w = F.wave, lo = lane & 15, hi = lane >> 4, d = lane, seg = w;
    const bool owave = w < 4;
    LAS bf16* QIN = (LAS bf16*)(F.lds + G_QIN); LAS bf16* KIN = (LAS bf16*)(F.lds + G_KIN); LAS bf16* KDT = (LAS bf16*)(F.lds + G_KDT); LAS bf16* VT = (LAS bf16*)(F.lds + G_VT);
    LAS float* SEG = (LAS float*)(F.lds + G_SEG); LAS float* DEC = (LAS float*)(F.lds + G_DEC);
    const int cb = n & 1;
    LAS bf16* STc = (LAS bf16*)(F.lds + (cb ? G_ST1 : G_ST0)); LAS bf16* STn = (LAS bf16*)(F.lds + (cb ? G_ST0 : G_ST1));
    LAS float* GLc = (LAS float*)(F.lds + (cb ? G_GLRS1 : G_GLRS0)); LAS float* GLn = (LAS float*)(F.lds + (cb ? G_GLRS0 : G_GLRS1));
    v2u gp[8]; gla_load_g(F, gp, b, h, n >= 1 ? n : 1);
    gla_load_set(F, nxt, b, h, n + 1 <= 32 ? n + 1 : 32);
    float la[8];
#pragma unroll
    for (int tt = 0; tt < 8; ++tt) { const int t = 8 * seg + tt; float pre = gbv;
#pragma unroll
        for (int r4 = 0; r4 < 4; ++r4) { const f32x4 g4 = *(const LAS f32x4*)(GLc + t * 16 + 4 * r4); pre += g4[0] * w2[4 * r4] + g4[1] * w2[4 * r4 + 1] + g4[2] * w2[4 * r4 + 2] + g4[3] * w2[4 * r4 + 3]; }
        const float ls = fminf(pre, 0.f) - __logf(1.0f + __expf(-fabsf(pre)));
        la[tt] = (n == 0 && t < 48) ? 0.f : ls * (1.0f / 16.0f); }
#pragma unroll
    for (int tt = 1; tt < 8; ++tt) la[tt] += la[tt - 1];
    SEG[seg * 64 + d] = la[7];
    GBAR();
    float off = 0.f, tot = 0.f;
#pragma unroll
    for (int s = 0; s < 8; ++s) { const float v = SEG[s * 64 + d]; tot += v; off += (s < seg) ? v : 0.f; }
    { float kdf[8];
#pragma unroll
      for (int tt = 0; tt < 8; ++tt) { const int t = 8 * seg + tt; const float bc = off + la[tt], qv = (lane & 1) ? bfhi(cur.q[tt]) : bflo(cur.q[tt]), kv = (lane & 1) ? bfhi(cur.k[tt]) : bflo(cur.k[tt]);
          const unsigned pqk = cvt2(qv * 0.125f * __expf(bc), kv * __expf(-bc));
          QIN[t * LQ + d] = (bf16)(pqk & 0xffffu); KIN[t * LQ + d] = (bf16)(pqk >> 16); kdf[tt] = kv * __expf(tot - bc); }
      v4u o; o.x = cvt2(kdf[0], kdf[1]); o.y = cvt2(kdf[2], kdf[3]); o.z = cvt2(kdf[4], kdf[5]); o.w = cvt2(kdf[6], kdf[7]);
      *(LAS v4u*)(KDT + d * LQ + 8 * seg) = o; }
    if (seg == 0) DEC[d] = __expf(tot);
    { const int j = tid & 63, e0 = 16 * (tid >> 6);
#pragma unroll
      for (int i = 0; i < 4; ++i) { const int e = e0 + 4 * i; VT[e * LQ + j] = (bf16)(cur.vp[i].x & 0xffffu); VT[(e + 1) * LQ + j] = (bf16)(cur.vp[i].x >> 16); VT[(e + 2) * LQ + j] = (bf16)(cur.vp[i].y & 0xffffu); VT[(e + 3) * LQ + j] = (bf16)(cur.vp[i].y >> 16); } }
    GBAR();
    if (owave) {
        if (n > 0) {
            const int mt = w;
            bf16x8 qf[2];
#pragma unroll
            for (int ks = 0; ks < 2; ++ks) qf[ks] = ldfrag(QIN, 16 * mt + lo, 32 * ks + 8 * hi);
            v4u pf[2];
#pragma unroll
            for (int jt = 0; jt < 4; ++jt) { f32x4 sc = {0.f, 0.f, 0.f, 0.f};
                if (jt <= mt) {
#pragma unroll
                    for (int ks = 0; ks < 2; ++ks) sc = __builtin_amdgcn_mfma_f32_16x16x32_bf16(ldfrag(KIN, 16 * jt + lo, 32 * ks + 8 * hi), qf[ks], sc, 0, 0, 0);
                    if (jt == mt) {
#pragma unroll
                        for (int x = 0; x < 4; ++x) sc[x] = (4 * hi + x <= lo) ? sc[x] : 0.f; }
                }
                const unsigned p0 = cvt2(sc[0], sc[1]), p1 = cvt2(sc[2], sc[3]);
                if (jt == 0) { pf[0].x = p0; pf[0].y = p1; } else if (jt == 1) { pf[0].z = p0; pf[0].w = p1; } else if (jt == 2) { pf[1].x = p0; pf[1].y = p1; } else { pf[1].z = p0; pf[1].w = p1; } }
            float ssq = 0.f;
#pragma unroll
            for (int et = 0; et < 8; ++et) { f32x4 oo = {0.f, 0.f, 0.f, 0.f};
#pragma unroll
                for (int ks = 0; ks < 2; ++ks) {
                    const v2u va = *(const LAS v2u*)(VT + (16 * et + lo) * LQ + 32 * ks + 4 * hi), vb = *(const LAS v2u*)(VT + (16 * et + lo) * LQ + 32 * ks + 16 + 4 * hi);
                    const v4u vx = {va.x, va.y, vb.x, vb.y};
                    oo = __builtin_amdgcn_mfma_f32_16x16x32_bf16(__builtin_bit_cast(bf16x8, vx), __builtin_bit_cast(bf16x8, pf[ks]), oo, 0, 0, 0);
                    oo = __builtin_amdgcn_mfma_f32_16x16x32_bf16(ldfrag(STc, 16 * et + lo, 32 * ks + 8 * hi), qf[ks], oo, 0, 0, 0); }
                acc8[et] = oo; ssq += (oo[0] * oo[0] + oo[1] * oo[1]) + (oo[2] * oo[2] + oo[3] * oo[3]); }
            ssq += __shfl_xor(ssq, 16); ssq += __shfl_xor(ssq, 32);
            const float rn = __builtin_amdgcn_rsqf(ssq * (1.0f / DV) + RMS_EPS);
            const size_t row = (size_t)b * SEQ + (size_t)(n - 1) * 64 + 16 * mt + lo;
#pragma unroll
            for (int et = 0; et < 8; ++et) { const int e0 = 16 * et + 4 * hi; const f32x4 ng = *(const LAS f32x4*)((const LAS float*)(F.lds + G_NG) + e0);
                const float g0 = bflo(gp[et].x), g1 = bfhi(gp[et].x), g2 = bflo(gp[et].y), g3 = bfhi(gp[et].y);
                v2u yo; yo.x = cvt2(acc8[et][0] * rn * ng[0] * siluf_(g0), acc8[et][1] * rn * ng[1] * siluf_(g1));
                yo.y = cvt2(acc8[et][2] * rn * ng[2] * siluf_(g2), acc8[et][3] * rn * ng[3] * siluf_(g3));
                *(v2u*)(F.y + row * D + CC + h * 128 + e0) = yo; }
        }
    } else {
        const int dt = w - 4;
        bf16x8 kf[2];
#pragma unroll
        for (int ks = 0; ks < 2; ++ks) kf[ks] = ldfrag(KDT, 16 * dt + lo, 32 * ks + 8 * hi);
        const f32x4 dc = *(const LAS f32x4*)(DEC + 16 * dt + 4 * hi);
#pragma unroll
        for (int et = 0; et < 8; ++et) { f32x4 s = acc8[et] * dc;
#pragma unroll
            for (int ks = 0; ks < 2; ++ks) s = __builtin_amdgcn_mfma_f32_16x16x32_bf16(kf[ks], ldfrag(VT, 16 * et + lo, 32 * ks + 8 * hi), s, 0, 0, 0);
            acc8[et] = s;
            v2u so; so.x = cvt2(s[0], s[1]); so.y = cvt2(s[2], s[3]);
            *(LAS v2u*)(STn + (16 * et + lo) * LQ + 16 * dt + 4 * hi) = so; }
        *(LAS f32x4*)(GLn + (tid - 256) * 4) = ring;
    }
    ring = gla_load_glr(F, b, n + 3 <= 32 ? n + 3 : 32);
#ifdef DBG_VM0
    asm volatile("s_waitcnt vmcnt(0)" ::: "memory");
#endif
    GBAR();
}
__device__ __forceinline__ void gla_chain(Frame& F, int bh) {
    const int b = bh >> 2, h = bh & 3, tid = F.tid, lane = F.lane, w = F.wave;
    float w2[16];
#pragma unroll
    for (int r = 0; r < 16; ++r) w2[r] = F.w_gate2[r * 256 + h * 64 + lane];
    const float gbv = F.gate_b[h * 64 + lane];
    RawSet A, B;
#pragma unroll
    for (int tt = 0; tt < 8; ++tt) { A.q[tt] = 0u; A.k[tt] = 0u; }
    if (w >= 6) {
#pragma unroll
        for (int tt = 0; tt < 8; ++tt) { const float* um = F.umeta + (size_t)(8 * (w - 6) + tt) * DIN; const unsigned qb = f2bf(um[OFF_Q + h * 64 + lane]), kb = f2bf(um[OFF_K + h * 64 + lane]); A.q[tt] = (lane & 1) ? (qb << 16) : qb; A.k[tt] = (lane & 1) ? (kb << 16) : kb; }
    }
    { const int j = tid & 63, e0 = 16 * (tid >> 6);
#pragma unroll
      for (int i = 0; i < 4; ++i) { float v[4];
#pragma unroll
          for (int x = 0; x < 4; ++x) v[x] = j < 48 ? 0.f : F.umeta[(size_t)(j - 48) * DIN + OFF_V + h * 128 + e0 + 4 * i + x];
          A.vp[i].x = pk2(v[0], v[1]); A.vp[i].y = pk2(v[2], v[3]); } }
    { LAS float* GL = (LAS float*)(F.lds + G_GLRS0);
#pragma unroll
      for (int k2 = 0; k2 < 2; ++k2) { const int idx = tid + k2 * NTHR, t = idx >> 4, r = idx & 15; GL[idx] = t < 48 ? 0.f : F.umeta[(size_t)(t - 48) * DIN + OFF_LR + r]; } }
    if (tid < DV) ((LAS float*)(F.lds + G_NG))[tid] = F.gnorm_g[tid];
    f32x4 ring1 = gla_load_glr(F, b, 1), ring0 = gla_load_glr(F, b, 2);
    f32x4 acc8[8];
#pragma unroll
    for (int i = 0; i < 8; ++i) acc8[i] = (f32x4){0.f, 0.f, 0.f, 0.f};
    GBAR();
    for (int n = 0; n < 32; n += 2) {
        gla_chunk(F, n, b, h, A, B, ring1, acc8, w2, gbv);
        gla_chunk(F, n + 1, b, h, B, A, ring0, acc8, w2, gbv);
    }
    gla_chunk(F, 32, b, h, A, B, ring1, acc8, w2, gbv);
}

__device__ __forceinline__ void p6_final(Frame& F) {
    const int gw = F.bid * NWAVES + F.wave, NGW = F.G * NWAVES;
    f32x4 g4[4];
#pragma unroll
    for (int j = 0; j < 4; ++j) g4[j] = *((const f32x4*)F.g_fin + F.lane + 64 * j);
    for (int m = gw; m < M; m += NGW) { const float rs = __builtin_amdgcn_rsqf(F.sq3[m] * (1.0f / D) + RMS_EPS); f32x4* o = (f32x4*)(F.out + (size_t)m * D) + F.lane;
#pragma unroll
        for (int j = 0; j < 4; ++j) o[64 * j] = o[64 * j] * rs * g4[j]; }
}

struct Args { const float* in[17]; float* out; unsigned char* ws; int ph_lo, ph_hi; };
static_assert(sizeof(Args) == 19 * 8 + 8, "Args has no padding");
__global__ void __launch_bounds__(NTHR) fwd_kernel(Args a) {
    extern __shared__ __attribute__((aligned(16))) unsigned char lds_raw[];
    cg::grid_group grid = cg::this_grid();
    Frame F;
    F.lds = (LAS unsigned char*)lds_raw;
    F.tid = threadIdx.x; F.lane = F.tid & 63; F.wave = __builtin_amdgcn_readfirstlane(F.tid >> 6); F.G = gridDim.x; F.bid = blockIdx.x;
    F.x = a.in[0]; F.meta = a.in[1]; F.g_mix = a.in[2]; F.w_in = a.in[3]; F.conv_w = a.in[4]; F.conv_b = a.in[5]; F.cln_g = a.in[6]; F.cln_b = a.in[7];
    F.w_gate2 = a.in[8]; F.gate_b = a.in[9]; F.gnorm_g = a.in[10]; F.w_out = a.in[11]; F.g_ffn = a.in[12]; F.w_fg = a.in[13]; F.w_fu = a.in[14]; F.w_fd = a.in[15]; F.g_fin = a.in[16];
    F.out = a.out;
    unsigned char* ws = a.ws;
    F.metab = (bf16*)(ws + WS_METAB); F.wlr = (bf16*)(ws + WS_WLR); F.rstdm = (float*)(ws + WS_RSTDM);
    F.ctl = (unsigned*)(ws + WS_CTL); F.rstd1 = (float*)(ws + WS_RSTD1); F.sq2 = (float*)(ws + WS_SQ2); F.sq3 = (float*)(ws + WS_SQ3); F.umeta = (float*)(ws + WS_UMETA); F.glr = (float*)(ws + WS_GLR); F.h2 = (float*)(ws + WS_H2);
    F.Wt_in = (bf16*)(ws + WS_WIN); F.Wt_out = (bf16*)(ws + WS_WOUT); F.Wt_gu = (bf16*)(ws + WS_WGU); F.Wt_dn = (bf16*)(ws + WS_WDN);
    F.hb = (bf16*)(ws + WS_HB); F.u = (bf16*)(ws + WS_U); F.y = (bf16*)(ws + WS_Y); F.act = (bf16*)(ws + WS_ACT);
    const int lo = a.ph_lo, hi = a.ph_hi;
    { volatile LAS unsigned* st = (volatile LAS unsigned*)(F.lds + LDS_BAR_OFF); if (F.tid < 2) st[F.tid] = 0u; }
    __syncthreads();
    XcdBarrier bar = xcd_barrier_post(F.ctl + CTL_BAR, (volatile LAS unsigned*)(F.lds + LDS_BAR_OFF));
#define IN(k) (lo <= (k) && (k) < hi)
#ifdef PROBE_A
#define STAMP(k) do { if (F.bid == 0 && F.tid == 0) ((volatile LAS unsigned long long*)(F.lds + 140000))[k] = __builtin_amdgcn_s_memrealtime(); } while (0)
#else
#define STAMP(k) do { } while (0)
#endif
#ifndef NSYNC
#define NSYNC 1
#endif
#define SEAM(k) do { if (IN(k) && IN((k) + 1)) { if ((k) == 0) grid.sync(); else xcd_barrier(bar); } STAMP((k) + 1); } while (0)
    STAMP(0);
    if (IN(0)) { p0_prep(F); __syncthreads(); if (REP0 > 1) { p0_prep(F); __syncthreads(); } }
    SEAM(0);
#define P1_BODY { pg8::Gemm g{F.hb, F.Wt_in, M, NU, D}; pg8::StaticOrder S; S.init(M, NU, F.G, F.bid); pg8::EpiU E{F.u, F.rstd1}; \
        pg8::gemm_phase<pg8::EpiU, pg8::StaticOrder, true, true>(F.lds, g, S, E); }
    if (IN(1)) { { for (int nt = F.bid * NWAVES + F.wave; nt < 161; nt += F.G * NWAVES) p1_meta_item(F, nt); }
        P1_BODY if (REP1 > 1) P1_BODY }
    SEAM(1);
#define P2_GLA { for (int it = F.bid; it < 64; it += F.G) gla_chain(F, it); __syncthreads(); }
#define P2_CONV(QW) { for (;;) { if (F.tid == 0) *(volatile LAS int*)(F.lds + CV_Q) = (int)atomicAdd(F.ctl + (QW), 1u); __syncthreads(); const int it = *(volatile LAS int*)(F.lds + CV_Q); if (it >= NB * 64) break; conv_item(F, it); } \
        __syncthreads(); }
    if (IN(2)) { P2_GLA if (REP2 == 2) P2_GLA P2_CONV(CTL_CONVQ) if (REP2 == 3) P2_CONV(CTL_CONVQ + 1) }
    SEAM(2);
#define P3_BODY(SQ) { pg8::Gemm g{F.y, F.Wt_out, M, D, D}; pg8::StaticOrder S; S.init(M, D, F.G, F.bid); pg8::EpiRes<true> E{F.x, F.h2, F.hb, SQ}; \
        pg8::gemm_phase<pg8::EpiRes<true>, pg8::StaticOrder, true, true>(F.lds, g, S, E); }
    if (IN(3)) { P3_BODY(F.sq2) if (REP3 > 1) P3_BODY(F.glr) }
    SEAM(3);
#define P4_BODY { pg8::Gemm g{F.hb, F.Wt_gu, M, 2 * DFF, D}; pg8::StaticOrder S; S.init(M, 2 * DFF, F.G, F.bid); pg8::EpiAct E{F.act, F.sq2}; \
        pg8::gemm_phase<pg8::EpiAct, pg8::StaticOrder, true, true>(F.lds, g, S, E); }
    if (IN(4)) { P4_BODY if (REP4 > 1) P4_BODY }
    SEAM(4);
#define P5_BODY(SQ) { pg8::Gemm g{F.act, F.Wt_dn, M, D, DFF}; pg8::StaticOrder S; S.init(M, D, F.G, F.bid); pg8::EpiRes<false> E{F.h2, F.out, nullptr, SQ}; \
        pg8::gemm_phase<pg8::EpiRes<false>, pg8::StaticOrder, true, true>(F.lds, g, S, E); }
    if (IN(5)) { P5_BODY(F.sq3) if (REP5 > 1) P5_BODY(F.glr) }
    SEAM(5);
    if (IN(6)) p6_final(F);
#ifdef PROBE_A
    STAMP(7);
    grid.sync();
    if (F.bid == 0 && F.tid == 0) { volatile LAS unsigned long long* T = (volatile LAS unsigned long long*)(F.lds + 140000);
        const float A = (float)(T[PROBE_A + 1] - T[PROBE_A]) * 0.01f, B = (float)(T[PROBE_B + 1] - T[PROBE_B]) * 0.01f;
        F.out[0] = 4.0f * A; const int nB = (int)(B * 1024.0f); for (int i = 0; i < nB; ++i) F.out[D + i] = 30.0f; }
#endif
#undef IN
#undef SEAM
}

extern "C" void kernel_launch(void* const* d_in, const int* in_sizes, int n_in, void* d_out, int out_size, void* d_ws, size_t ws_size, hipStream_t stream) {
    static int grid = 0;
    if (grid == 0) {
        if (n_in != 17 || in_sizes[0] != M * D || out_size != M * D || ws_size < WS_END) { fprintf(stderr, "kernel_launch: unexpected shapes (n_in %d in0 %d out %d ws %zu)\n", n_in, n_in > 0 ? in_sizes[0] : -1, out_size, ws_size); grid = -1; return; }
        int dev = 0, cus = 0, per_cu = 0;
        if (hipGetDevice(&dev) != hipSuccess || hipDeviceGetAttribute(&cus, hipDeviceAttributeMultiprocessorCount, dev) != hipSuccess) { grid = -1; return; }
        if (hipFuncSetAttribute((const void*)fwd_kernel, hipFuncAttributeMaxDynamicSharedMemorySize, LDS_BYTES) != hipSuccess) { fprintf(stderr, "kernel_launch: hipFuncSetAttribute failed\n"); grid = -1; return; }
        if (hipOccupancyMaxActiveBlocksPerMultiprocessor(&per_cu, (const void*)fwd_kernel, NTHR, LDS_BYTES) != hipSuccess || per_cu < 1) { fprintf(stderr, "kernel_launch: occupancy query says %d blocks per CU\n", per_cu); (void)hipGetLastError(); per_cu = 1; }
        grid = cus * 1;
        fprintf(stderr, "kernel_launch: grid %d (cus %d, per_cu %d)\n", grid, cus, per_cu);
    }
    if (grid < 0) return;
    if (hipMemsetAsync((char*)d_ws + WS_CTL, 0, CTL_ZERO_BYTES, stream) != hipSuccess) { fprintf(stderr, "kernel_launch: memset failed\n"); return; }
    Args a{};
    for (int i = 0; i < 17; ++i) a.in[i] = (const float*)d_in[i];
    a.out = (float*)d_out; a.ws = (unsigned char*)d_ws;
#if MK_N_LAUNCHES == 1
    a.ph_lo = 0; a.ph_hi = N_PHASES;
    { void* args[] = {&a}; hipError_t e = hipLaunchCooperativeKernel((const void*)fwd_kernel, dim3(grid), dim3(NTHR), args, LDS_BYTES, stream);
      if (e != hipSuccess) fprintf(stderr, "kernel_launch: cooperative launch failed: %s\n", hipGetErrorString(e)); }
#else
    for (int p = 0; p < N_PHASES; ++p) { a.ph_lo = p; a.ph_hi = p + 1; void* args[] = {&a};
        hipError_t e = hipLaunchCooperativeKernel((const void*)fwd_kernel, dim3(grid), dim3(NTHR), args, LDS_BYTES, stream);
        if (e != hipSuccess) { fprintf(stderr, "kernel_launch: launch %d failed: %s\n", p, hipGetErrorString(e)); break; } }
#endif
}
```
